# Optimizing an MI355X kernel written in HIP

```python
import functools
import jax, jax.numpy as jnp
from jax import lax
import numpy as np

D_MODEL = 1024
BATCH = 32
SEQ = 256
DEPTH = 4
DEC_BATCH = 8
DEC_SEQ = 2048
PAST_LEN = 512

GRID_W = 64
HEAD_DIM = 64
NA_HEADS = 8
NA_WIN_R = 8
NA_WIN_C = 16
GQA_HEADS = 8
GQA_KV_HEADS = 2
BRANCH_W = 512
N_BRANCH = 4
CONV_K = 3
POOL_WINDOWS = (2, 4, 8, 16)
POOL_GROUPS = 4
POOL_GW = BRANCH_W // POOL_GROUPS
N_EXPERTS = 16
EXPERT_FF = 1024
EC_CAPACITY = 2
Q_BLOCK = 128
ROPE_THETA = 10000.0
LN_EPS = 1e-6
RMS_EPS = 1e-6
N_MOD = 6
ADA_INIT = 0.5
DEEPNORM_ALPHA = (2 * DEPTH) ** 0.25
DEEPNORM_BETA = (8 * DEPTH) ** -0.25
NA_W = NA_HEADS * HEAD_DIM
GQA_QW = GQA_HEADS * HEAD_DIM
GQA_KW = GQA_KV_HEADS * HEAD_DIM
IN_SIZES = (NA_W, NA_W, NA_W, GQA_QW, GQA_KW, GQA_KW, BRANCH_W, BRANCH_W, BRANCH_W, BRANCH_W, N_BRANCH * D_MODEL)
IN_OFFSETS = tuple(int(v) for v in np.cumsum(IN_SIZES)[:-1])
IN_W = int(sum(IN_SIZES))

kernel_name = "hybrid_diffusion_gated_branch_trunk_step"


def layer_norm(x, g, b):
    xf = x.astype(jnp.float32)
    mu = jnp.mean(xf, -1, keepdims=True)
    var = jnp.mean(jnp.square(xf - mu), -1, keepdims=True)
    return ((xf - mu) * lax.rsqrt(var + LN_EPS) * g + b).astype(x.dtype)


def rms_norm(x, g):
    xf = x.astype(jnp.float32)
    return (xf * lax.rsqrt(jnp.mean(xf * xf, -1, keepdims=True) + RMS_EPS) * g).astype(x.dtype)


def adaln(cvec, w, b):
    return jnp.einsum("bd,dk->bk", jax.nn.silu(cvec), w) + b


def modulate(x, shift, scale):
    return x * (1 + scale) + shift


def _rotate(xh, ang):
    x1, x2 = jnp.split(xh.astype(jnp.float32), 2, axis=-1)
    cos = jnp.cos(ang)[None, :, None, :]
    sin = jnp.sin(ang)[None, :, None, :]
    return jnp.concatenate([x1 * cos - x2 * sin, x1 * sin + x2 * cos], -1)


def axial_rope(x):
    L = x.shape[1]
    t = jnp.arange(L)
    n_freq = HEAD_DIM // 4
    inv = ROPE_THETA ** (-jnp.arange(n_freq, dtype=jnp.float32) / n_freq)
    ang_r = (t // GRID_W).astype(jnp.float32)[:, None] * inv
    ang_c = (t % GRID_W).astype(jnp.float32)[:, None] * inv
    xr, xc = jnp.split(x, 2, axis=-1)
    return jnp.concatenate([_rotate(xr, ang_r), _rotate(xc, ang_c)], -1).astype(x.dtype)


def blocked_attention(q, k, v):
    B, Lq, H, dh = q.shape
    G = k.shape[2]
    R = H // G
    scale = dh ** -0.5
    nb = Lq // Q_BLOCK
    qb = q.reshape(B, nb, Q_BLOCK, G, R, dh).transpose(1, 0, 2, 3, 4, 5)

    def one_block(qi):
        s = jnp.einsum("bqgrd,bkgd->bgrqk", qi, k, preferred_element_type=jnp.float32) * scale
        p = jax.nn.softmax(s, axis=-1).astype(v.dtype)
        return jnp.einsum("bgrqk,bkgd->bqgrd", p, v)

    o = lax.map(one_block, qb)
    return o.transpose(1, 0, 2, 3, 4, 5).reshape(B, Lq, H * dh)


def neighbourhood_attention(q, k, v, kc, vc, rpb):
    B, L, H, dh = q.shape
    rows = L // GRID_W
    wr = min(NA_WIN_R, rows)
    wc = NA_WIN_C
    scale = dh ** -0.5
    qg = q.reshape(B, rows, GRID_W, H, dh).transpose(1, 0, 2, 3, 4)
    kg = k.reshape(B, rows, GRID_W, H, dh)
    vg = v.reshape(B, rows, GRID_W, H, dh)
    cols = np.arange(GRID_W)
    col_start = np.clip(cols - wc // 2, 0, GRID_W - wc)
    col_idx = col_start[:, None] + np.arange(wc)[None, :]
    col_rel = col_idx - cols[:, None] + (NA_WIN_C - 1)
    row_starts = jnp.asarray(np.clip(np.arange(rows) - wr // 2, 0, rows - wr), jnp.int32)
    row_ids = jnp.arange(rows, dtype=jnp.int32)

    def one_row(args):
        qr, r, rs = args
        k_rows = lax.dynamic_slice_in_dim(kg, rs, wr, axis=1)
        v_rows = lax.dynamic_slice_in_dim(vg, rs, wr, axis=1)
        k_win = k_rows[:, :, col_idx]
        v_win = v_rows[:, :, col_idx]
        row_rel = rs + jnp.arange(wr) - r + (NA_WIN_R - 1)
        bias = rpb[:, row_rel[:, None, None], col_rel[None, :, :]]
        s_loc = jnp.einsum("bqhd,biqjhd->bhqij", qr, k_win, preferred_element_type=jnp.float32) * scale
        s_loc = s_loc + bias.transpose(0, 2, 1, 3)[None]
        s_ctx = jnp.einsum("bqhd,bphd->bhqp", qr, kc, preferred_element_type=jnp.float32) * scale
        s = jnp.concatenate([s_loc.reshape(B, H, GRID_W, wr * wc), s_ctx], axis=-1)
        p = jax.nn.softmax(s, axis=-1).astype(v.dtype)
        p_loc = p[..., : wr * wc].reshape(B, H, GRID_W, wr, wc)
        p_ctx = p[..., wr * wc:]
        return (jnp.einsum("bhqij,biqjhd->bqhd", p_loc, v_win)
                + jnp.einsum("bhqp,bphd->bqhd", p_ctx, vc))

    o = lax.map(one_row, (qg, row_ids, row_starts))
    return o.transpose(1, 0, 2, 3, 4).reshape(B, L, H * dh)


def short_conv(xb, xc, xh, w, b):
    u = xc * xh
    y = lax.conv_general_dilated(u, w[:, None, :], window_strides=(1,),
                                 padding=[(CONV_K // 2, CONV_K // 2)],
                                 dimension_numbers=("NWC", "WIO", "NWC"),
                                 feature_group_count=BRANCH_W) + b
    return xb * y


def multiscale_pool(u, w_grp, scale):
    B, L, _ = u.shape
    uf = u.astype(jnp.float32)
    cs = jnp.concatenate([jnp.zeros((B, 1, BRANCH_W), jnp.float32), jnp.cumsum(uf, axis=1)], axis=1)
    t = jnp.arange(L)
    outs = []
    for g, win in enumerate(POOL_WINDOWS):
        lo = jnp.clip(t - win // 2, 0, L)
        hi = jnp.clip(t + win // 2, 0, L)
        sl = slice(g * POOL_GW, (g + 1) * POOL_GW)
        csg = cs[..., sl]
        cnt = (hi - lo).astype(jnp.float32)[None, :, None]
        outs.append((csg[:, hi] - csg[:, lo]) / cnt - uf[..., sl])
    pooled = jnp.stack(outs, axis=2).astype(u.dtype)
    mixed = jnp.einsum("blgc,gcd->blgd", pooled, w_grp)
    return mixed.reshape(B, L, BRANCH_W) * scale


def merge_branches(branches, gate_logits, w_branch, w_out):
    B, L, _ = gate_logits.shape
    bstack = jnp.stack(branches, axis=2)
    proj = jnp.einsum("blnc,ncd->blnd", bstack, w_branch)
    gates = jax.nn.sigmoid(gate_logits.reshape(B, L, N_BRANCH, D_MODEL))
    merged = jnp.sum(gates * proj, axis=2)
    return jnp.einsum("bld,de->ble", merged, w_out)


def split_inputs(h, w_in):
    return jnp.split(jnp.einsum("bld,dk->blk", h, w_in), IN_OFFSETS, axis=-1)


def mixer_context(h, p):
    B, L, _ = h.shape
    (na_q, na_k, na_v, g_q, g_k, g_v, cv_b, cv_c, cv_h, pl_u, gate_logits) = split_inputs(h, p["w_in"])
    na_q = na_q.reshape(B, L, NA_HEADS, HEAD_DIM)
    na_k = na_k.reshape(B, L, NA_HEADS, HEAD_DIM)
    na_v = na_v.reshape(B, L, NA_HEADS, HEAD_DIM)
    o_na = blocked_attention(na_q, na_k, na_v)
    g_q = rms_norm(g_q.reshape(B, L, GQA_HEADS, HEAD_DIM), p["qn_g"])
    g_k = rms_norm(g_k.reshape(B, L, GQA_KV_HEADS, HEAD_DIM), p["kn_g"])
    g_v = g_v.reshape(B, L, GQA_KV_HEADS, HEAD_DIM)
    o_gqa = blocked_attention(g_q, g_k, g_v)
    o_conv = short_conv(cv_b, cv_c, cv_h, p["conv_w"], p["conv_b"])
    o_pool = multiscale_pool(pl_u, p["pool_w"], p["pool_scale"])
    y = merge_branches((o_na, o_gqa, o_conv, o_pool), gate_logits, p["w_branch"], p["w_out"])
    return y, (na_k, na_v, g_k, g_v)


def mixer_latent(h, p, na_kc, na_vc, gqa_kc, gqa_vc):
    B, L, _ = h.shape
    (na_q, na_k, na_v, g_q, g_k, g_v, cv_b, cv_c, cv_h, pl_u, gate_logits) = split_inputs(h, p["w_in"])
    o_na = neighbourhood_attention(na_q.reshape(B, L, NA_HEADS, HEAD_DIM),
                                   na_k.reshape(B, L, NA_HEADS, HEAD_DIM),
                                   na_v.reshape(B, L, NA_HEADS, HEAD_DIM),
                                   na_kc, na_vc, p["na_rpb"])
    g_q = axial_rope(rms_norm(g_q.reshape(B, L, GQA_HEADS, HEAD_DIM), p["qn_g"]))
    g_k = axial_rope(rms_norm(g_k.reshape(B, L, GQA_KV_HEADS, HEAD_DIM), p["kn_g"]))
    g_v = g_v.reshape(B, L, GQA_KV_HEADS, HEAD_DIM)
    o_gqa = blocked_attention(g_q, jnp.concatenate([g_k, gqa_kc], axis=1),
                              jnp.concatenate([g_v, gqa_vc], axis=1))
    o_conv = short_conv(cv_b, cv_c, cv_h, p["conv_w"], p["conv_b"])
    o_pool = multiscale_pool(pl_u, p["pool_w"], p["pool_scale"])
    y = merge_branches((o_na, o_gqa, o_conv, o_pool), gate_logits, p["w_branch"], p["w_out"])
    return y, None


def expert_choice_moe(x, w_router, w_gate, w_up, w_down):
    B, L, D = x.shape
    n = B * L
    cap = EC_CAPACITY * n // N_EXPERTS
    xt = x.reshape(n, D)
    aff = jax.nn.softmax(jnp.einsum("nd,de->ne", xt, w_router, preferred_element_type=jnp.float32), axis=-1)
    g, idx = lax.top_k(aff.T, cap)
    xs = xt[idx]
    hdn = jax.nn.silu(jnp.einsum("ecd,edf->ecf", xs, w_gate)) * jnp.einsum("ecd,edf->ecf", xs, w_up)
    ye = jnp.einsum("ecf,efd->ecd", hdn, w_down) * g[..., None].astype(x.dtype)
    y = jnp.zeros_like(xt).at[idx.reshape(-1)].add(ye.reshape(-1, D))
    return y.reshape(B, L, D)


def post_norm_layer(x, mod, mix_fn, p):
    shift1, scale1, gate1, shift2, scale2, gate2 = jnp.split(mod, N_MOD, axis=-1)
    y_mix, ctx = mix_fn(modulate(x, shift1, scale1))
    x = layer_norm(DEEPNORM_ALPHA * x + gate1 * y_mix, p["ln1_g"], p["ln1_b"])
    y_ff = expert_choice_moe(modulate(x, shift2, scale2), p["w_router"], p["w_gate"], p["w_up"], p["w_down"])
    x = layer_norm(DEEPNORM_ALPHA * x + gate2 * y_ff, p["ln2_g"], p["ln2_b"])
    return x, ctx


def setup_inputs(seed: int = 0) -> dict:
    key = jax.random.key(seed)
    ks = jax.random.split(key, 32)
    nrm = lambda k, s: jax.random.normal(k, s, jnp.float32)
    D = D_MODEL
    return {
        "x_prompt": nrm(ks[0], (BATCH, SEQ, D)),
        "x_sample": nrm(ks[1], (DEC_BATCH, DEC_SEQ, D)),
        "cache_na_k": nrm(ks[2], (DEC_BATCH, DEPTH, PAST_LEN, NA_HEADS, HEAD_DIM)),
        "cache_na_v": nrm(ks[3], (DEC_BATCH, DEPTH, PAST_LEN, NA_HEADS, HEAD_DIM)),
        "cache_gqa_k": nrm(ks[4], (DEC_BATCH, DEPTH, PAST_LEN, GQA_KV_HEADS, HEAD_DIM)),
        "cache_gqa_v": nrm(ks[5], (DEC_BATCH, DEPTH, PAST_LEN, GQA_KV_HEADS, HEAD_DIM)),
        "c": nrm(ks[6], (DEC_BATCH, D)),
        "c_ctx": nrm(ks[7], (D,)),
        "w_ada": nrm(ks[8], (DEPTH, D, N_MOD * D)) * (ADA_INIT * D ** -0.5),
        "b_ada": nrm(ks[9], (DEPTH, N_MOD * D)) * 0.01,
        "w_in": nrm(ks[10], (DEPTH, D, IN_W)) * D ** -0.5,
        "na_rpb": nrm(ks[11], (DEPTH, NA_HEADS, 2 * NA_WIN_R - 1, 2 * NA_WIN_C - 1)) * 0.1,
        "qn_g": 1.0 + 0.01 * nrm(ks[12], (DEPTH, HEAD_DIM)),
        "kn_g": 1.0 + 0.01 * nrm(ks[13], (DEPTH, HEAD_DIM)),
        "conv_w": nrm(ks[14], (DEPTH, CONV_K, BRANCH_W)) * CONV_K ** -0.5,
        "conv_b": nrm(ks[15], (DEPTH, BRANCH_W)) * 0.01,
        "pool_w": nrm(ks[16], (DEPTH, POOL_GROUPS, POOL_GW, POOL_GW)) * POOL_GW ** -0.5,
        "pool_scale": 1.0 + 0.01 * nrm(ks[17], (DEPTH, BRANCH_W)),
        "w_branch": nrm(ks[18], (DEPTH, N_BRANCH, BRANCH_W, D)) * BRANCH_W ** -0.5,
        "w_out": nrm(ks[19], (DEPTH, D, D)) * (DEEPNORM_BETA * D ** -0.5),
        "ln1_g": 1.0 + 0.01 * nrm(ks[20], (DEPTH, D)),
        "ln1_b": 0.01 * nrm(ks[21], (DEPTH, D)),
        "ln2_g": 1.0 + 0.01 * nrm(ks[22], (DEPTH, D)),
        "ln2_b": 0.01 * nrm(ks[23], (DEPTH, D)),
        "w_router": nrm(ks[24], (DEPTH, D, N_EXPERTS)) * D ** -0.5,
        "w_gate": nrm(ks[25], (DEPTH, N_EXPERTS, D, EXPERT_FF)) * D ** -0.5,
        "w_up": nrm(ks[26], (DEPTH, N_EXPERTS, D, EXPERT_FF)) * D ** -0.5,
        "w_down": nrm(ks[27], (DEPTH, N_EXPERTS, EXPERT_FF, D)) * (DEEPNORM_BETA * EXPERT_FF ** -0.5),
    }


def reference(x_prompt, x_sample, cache_na_k, cache_na_v, cache_gqa_k, cache_gqa_v, c, c_ctx,
              w_ada, b_ada, w_in, na_rpb, qn_g, kn_g, conv_w, conv_b, pool_w, pool_scale,
              w_branch, w_out, ln1_g, ln1_b, ln2_g, ln2_b, w_router, w_gate, w_up, w_down):
    y_p = x_prompt
    y_s = x_sample
    na_k_list, na_v_list, gqa_k_list, gqa_v_list = [], [], [], []
    for l in range(DEPTH):
        p = {"w_in": w_in[l], "na_rpb": na_rpb[l], "qn_g": qn_g[l], "kn_g": kn_g[l],
             "conv_w": conv_w[l], "conv_b": conv_b[l], "pool_w": pool_w[l], "pool_scale": pool_scale[l],
             "w_branch": w_branch[l], "w_out": w_out[l], "ln1_g": ln1_g[l], "ln1_b": ln1_b[l],
             "ln2_g": ln2_g[l], "ln2_b": ln2_b[l], "w_router": w_router[l], "w_gate": w_gate[l],
             "w_up": w_up[l], "w_down": w_down[l]}
        mod_ctx = adaln(c_ctx[None, :], w_ada[l], b_ada[l])[:, None, :]
        mod_lat = adaln(c, w_ada[l], b_ada[l])[:, None, :]
        y_p, (k_na, v_na, k_g, v_g) = post_norm_layer(y_p, mod_ctx, functools.partial(mixer_context, p=p), p)
        na_k_list.append(k_na)
        na_v_list.append(v_na)
        gqa_k_list.append(k_g)
        gqa_v_list.append(v_g)
        mix_lat = functools.partial(mixer_latent, p=p, na_kc=cache_na_k[:, l], na_vc=cache_na_v[:, l],
                                    gqa_kc=cache_gqa_k[:, l], gqa_vc=cache_gqa_v[:, l])
        y_s, _ = post_norm_layer(y_s, mod_lat, mix_lat, p)
    state_na_k = jnp.stack(na_k_list, axis=1)
    state_na_v = jnp.stack(na_v_list, axis=1)
    state_gqa_k = jnp.stack(gqa_k_list, axis=1)
    state_gqa_v = jnp.stack(gqa_v_list, axis=1)
    return (y_p, y_s, state_na_k, state_na_v, state_gqa_k, state_gqa_v)
```

```cpp
#include <hip/hip_runtime.h>
#include <cstdio>
#include <cstdint>

#ifndef MK_ONE_LAUNCH
#define MK_ONE_LAUNCH 1
#endif

#define LAS __attribute__((address_space(3)))
typedef unsigned short bf16_t;
typedef short bf16x8 __attribute__((ext_vector_type(8)));
typedef float f32x4 __attribute__((ext_vector_type(4)));
typedef float f32x16 __attribute__((ext_vector_type(16)));
typedef unsigned u32x4 __attribute__((ext_vector_type(4)));
typedef unsigned u32x2 __attribute__((ext_vector_type(2)));

constexpr int D = 1024, NCTX = 8192, NLAT = 16384, NTOK = 24576, DEPTH = 4, INW = 8448;
constexpr int C_NAQ = 0, C_NAK = 512, C_NAV = 1024, C_GQ = 1536, C_GK = 2048, C_GV = 2176, C_CVB = 2304, C_CVC = 2816, C_CVH = 3328, C_PLU = 3840, C_GATE = 4352;
#ifndef C_F8_START
#define C_F8_START C_GATE
#endif
constexpr int C_F8 = C_F8_START, NF8 = INW - C_F8;
constexpr int BRW = 2048;
constexpr float ALPHA = 1.6817928305074290f;
constexpr float LOG2E = 1.4426950408889634f;
constexpr float C2 = 0.125f * 1.4426950408889634f;
constexpr size_t O_X = 0, O_SNAK = (size_t)NTOK * D, O_SNAV = O_SNAK + 16777216, O_SGK = O_SNAV + 16777216, O_SGV = O_SGK + 4194304, O_END = O_SGV + 4194304;
constexpr size_t MiB = 1u << 20;
constexpr size_t WS_CTL = 0, CTL_BYTES = 1 * MiB;
constexpr size_t WS_MOD = 1 * MiB;
constexpr size_t WS_ROPE = 2 * MiB - 16384;
constexpr size_t WS_AFF = 2 * MiB, WS_AFFT = WS_AFF + 1572864, WS_SLOT = WS_AFFT + 1572864, WS_IDX = WS_SLOT + 1572864;
constexpr size_t WS_WI = 8 * MiB, WS_WBR = 74 * MiB, WS_WO = 90 * MiB;
constexpr size_t WS_WGU8 = 98 * MiB, WS_WD8 = 226 * MiB, WS_WI8 = 290 * MiB, WS_H8 = 320 * MiB;
constexpr size_t WS_CNAK = 482 * MiB, WS_CNAV = 498 * MiB, WS_CGK = 514 * MiB, WS_CGV = 518 * MiB;
constexpr size_t WS_H = 522 * MiB, WS_BIG = 570 * MiB, WS_V = WS_BIG, WS_HDN = WS_BIG + 96 * MiB, WS_YE = WS_BIG + 192 * MiB;
constexpr size_t WS_BR = 966 * MiB, WS_MRG = 1062 * MiB, WS_XB = 1110 * MiB, WS_END = 1158 * MiB;
static_assert(WS_IDX + 49152 * 4 <= WS_WI && WS_BIG + (size_t)NTOK * INW * 2 <= WS_BR, "ws map");
constexpr int CW_BAR = 4096;
constexpr int RING_BYTES = 131072, MISC_OFF = RING_BYTES + 320, LDS_BYTES = 147456;

struct Args { const float* in[28]; float* out; unsigned char* ws; int ph_lo, ph_hi; };
enum { I_XP = 0, I_XS, I_CNAK, I_CNAV, I_CGK, I_CGV, I_C, I_CCTX, I_WADA, I_BADA, I_WIN, I_RPB, I_QNG, I_KNG, I_CONVW, I_CONVB, I_POOLW, I_POOLS, I_WBR, I_WOUT, I_LN1G, I_LN1B, I_LN2G, I_LN2B, I_WR, I_WG, I_WU, I_WDN };

#define LDS_WAIT() asm volatile("s_waitcnt lgkmcnt(0)" ::: "memory")
__device__ __forceinline__ unsigned cvt_pk_bf16(float lo, float hi) { unsigned r; asm("v_cvt_pk_bf16_f32 %0, %1, %2" : "=v"(r) : "v"(lo), "v"(hi)); return r; }
typedef _Float16 h16x2 __attribute__((ext_vector_type(2)));
__device__ __forceinline__ unsigned cvt_pk_f16(float lo, float hi) { const h16x2 v = {(_Float16)lo, (_Float16)hi}; return __builtin_bit_cast(unsigned, v); }
__device__ __forceinline__ float h16lo(unsigned w) { return (float)__builtin_bit_cast(h16x2, w)[0]; }
__device__ __forceinline__ float h16hi(unsigned w) { return (float)__builtin_bit_cast(h16x2, w)[1]; }
__device__ __forceinline__ unsigned cvt4_fp8(float a, float b, float c, float d) { int w = 0; w = __builtin_amdgcn_cvt_pk_fp8_f32(a, b, w, false); w = __builtin_amdgcn_cvt_pk_fp8_f32(c, d, w, true); return (unsigned)w; }
typedef float f32x2_t __attribute__((ext_vector_type(2)));
__device__ __forceinline__ void fp8x8_to_f32(u32x2 w, float (&o)[8]) { const f32x2_t a = __builtin_amdgcn_cvt_pk_f32_fp8((int)w.x, false), b = __builtin_amdgcn_cvt_pk_f32_fp8((int)w.x, true), c = __builtin_amdgcn_cvt_pk_f32_fp8((int)w.y, false), d = __builtin_amdgcn_cvt_pk_f32_fp8((int)w.y, true);
    o[0] = a[0]; o[1] = a[1]; o[2] = b[0]; o[3] = b[1]; o[4] = c[0]; o[5] = c[1]; o[6] = d[0]; o[7] = d[1]; }
__device__ __forceinline__ unsigned pack4_u8(float a, float b, float c, float d) { unsigned w = 0u; w = __builtin_amdgcn_cvt_pk_u8_f32(a, 0, w); w = __builtin_amdgcn_cvt_pk_u8_f32(b, 1, w); w = __builtin_amdgcn_cvt_pk_u8_f32(c, 2, w); w = __builtin_amdgcn_cvt_pk_u8_f32(d, 3, w); return w; }
__device__ __forceinline__ void u8x8_to_f32(u32x2 w, float (&o)[8]) { o[0] = (float)(w.x & 0xffu); o[1] = (float)((w.x >> 8) & 0xffu); o[2] = (float)((w.x >> 16) & 0xffu); o[3] = (float)(w.x >> 24);
    o[4] = (float)(w.y & 0xffu); o[5] = (float)((w.y >> 8) & 0xffu); o[6] = (float)((w.y >> 16) & 0xffu); o[7] = (float)(w.y >> 24); }
__device__ __forceinline__ float sat448(float v) { return __builtin_amdgcn_fmed3f(v, -448.0f, 448.0f); }
__device__ __forceinline__ unsigned cvt4_fp8_sat(float a, float b, float c, float d) { return cvt4_fp8(sat448(a), sat448(b), sat448(c), sat448(d)); }
constexpr float W8_SCALE = 64.0f;
__device__ __forceinline__ float bflo(unsigned w) { return __uint_as_float(w << 16); }
__device__ __forceinline__ float bfhi(unsigned w) { return __uint_as_float(w & 0xffff0000u); }
__device__ __forceinline__ int opaque_v(int v) { asm volatile("" : "+v"(v)); return v; }
__device__ __forceinline__ int opaque_s(int v) { v = __builtin_amdgcn_readfirstlane(v); asm volatile("" : "+s"(v)); return v; }
__device__ __forceinline__ float wave_sum(float v) {
#pragma unroll
    for (int o = 1; o < 64; o <<= 1) v += __shfl_xor(v, o);
    return v;
}
__device__ __forceinline__ float fast_exp2(float x) { return __builtin_amdgcn_exp2f(x); }
__device__ __forceinline__ float sigmoidf_(float z) { return __builtin_amdgcn_rcpf(1.0f + fast_exp2(-z * LOG2E)); }
__device__ __forceinline__ int modrow_of_tok(int tok) { return tok < NCTX ? 0 : 1 + ((tok - NCTX) >> 11); }

#define XB_TMO      128
#define XB_XCNT(j)  (256  + 64 * (j))
#define XB_XSUB(j)  (1280 + 64 * (j))
#define XB_XGEN(j)  (2304 + 64 * (j))
#define XB_TOP      3328
#define XB_TOPGEN   3392
#define XCD_BAR_WORDS 3456
#define XB_SPIN_CAP (1u << 18)
__device__ __forceinline__ unsigned xb_ld(unsigned* p)              { return __hip_atomic_load(p, __ATOMIC_RELAXED, __HIP_MEMORY_SCOPE_AGENT); }
__device__ __forceinline__ unsigned xb_add(unsigned* p, unsigned v) { return __hip_atomic_fetch_add(p, v, __ATOMIC_RELAXED, __HIP_MEMORY_SCOPE_AGENT); }
__device__ __forceinline__ unsigned xb_xcc_id() { return (unsigned)__builtin_amdgcn_s_getreg((3 << 11) | 20) & 0xFu; }
#define XB_SPIN(cond, bar) do { unsigned _sp = 0; while (cond) { __builtin_amdgcn_s_sleep(1); \
    if ((++_sp & 255u) == 0u) { if (xb_ld(&(bar)[XB_TMO])) break; if (_sp > XB_SPIN_CAP) { atomicAdd(&(bar)[XB_TMO], 1u); break; } } } } while (0)
struct XcdBarrier { unsigned* bar; unsigned x; volatile LAS unsigned* st; };
__device__ __forceinline__ XcdBarrier xcd_barrier_post(unsigned* bar, volatile LAS unsigned* st) {
    XcdBarrier b; b.bar = bar; b.x = xb_xcc_id(); b.st = st;
    if (threadIdx.x == 0) (void)xb_add(&bar[XB_XCNT(b.x)], 1u);
    return b;
}
__device__ __forceinline__ void xcd_barrier_complete(unsigned* bar, unsigned x, unsigned& nloc, unsigned& nx) {
    const unsigned G = gridDim.x * gridDim.y * gridDim.z;
    unsigned sum, cnt, mine, sp = 0u;
    for (;;) {
        sum = 0u; cnt = 0u; mine = 0u;
#pragma unroll
        for (unsigned j = 0; j < 16; ++j) { const unsigned c = xb_ld(&bar[XB_XCNT(j)]); sum += c; cnt += (c > 0u) ? 1u : 0u; mine = (j == x) ? c : mine; }
        if (sum == G) break;
        __builtin_amdgcn_s_sleep(1);
        if ((++sp & 255u) == 0u) { if (xb_ld(&bar[XB_TMO])) break; if (sp > XB_SPIN_CAP) { atomicAdd(&bar[XB_TMO], 1u); break; } }
    }
    nloc = mine > 0u ? mine : 1u; nx = cnt > 0u ? cnt : 1u;
}
__device__ __forceinline__ void xcd_barrier(const XcdBarrier& b) {
    asm volatile("s_waitcnt vmcnt(0)" ::: "memory");
    __syncthreads();
    if (threadIdx.x == 0) {
        unsigned* bar = b.bar;
        __builtin_amdgcn_s_waitcnt(0);
        unsigned nloc = b.st[0], nx = b.st[1];
        if (nloc == 0u) { xcd_barrier_complete(bar, b.x, nloc, nx); b.st[0] = nloc; b.st[1] = nx; }
        const unsigned old = xb_add(&bar[XB_XSUB(b.x)], 1u);
        const unsigned gen = old / nloc;
        if (old + 1u == (gen + 1u) * nloc) {
            __builtin_amdgcn_fence(__ATOMIC_RELEASE, "agent");
            asm volatile("s_waitcnt vmcnt(0)" ::: "memory");
            const unsigned og = xb_add(&bar[XB_TOP], 1u);
            const unsigned tg = og / nx;
            if (og + 1u == (tg + 1u) * nx) xb_add(&bar[XB_TOPGEN], 1u);
            else XB_SPIN(xb_ld(&bar[XB_TOPGEN]) == tg, bar);
            __builtin_amdgcn_fence(__ATOMIC_ACQUIRE, "agent");
            xb_add(&bar[XB_XGEN(b.x)], 1u);
            asm volatile("s_waitcnt vmcnt(0)" ::: "memory");
        } else {
            XB_SPIN(xb_ld(&bar[XB_XGEN(b.x)]) == gen, bar);
            __builtin_amdgcn_fence(__ATOMIC_ACQUIRE, "agent");
            asm volatile("s_waitcnt vmcnt(0)" ::: "memory");
        }
    }
    __syncthreads();
}

namespace pg8 {
constexpr int BM = 256, BK = 64, HALF = 128, HTB = HALF * BK * 2, STAGE_BYTES = 8 * HTB;
__device__ __forceinline__ int lds_byte(int r, int c) { const int st = (r >> 4) * 2 + (c >> 5), rr = r & 15, cc = c & 31, ob = rr * 64 + cc * 2; return st * 1024 + (ob ^ (((ob >> 9) & 1) << 5)); }
__device__ __forceinline__ void stage_rc(int b, int& R, int& C) { const int st = b / 1024, sb = b % 1024, swz = sb ^ (((sb >> 9) & 1) << 5); R = (st >> 1) * 16 + swz / 64; C = (st & 1) * 32 + (swz % 64) / 2; }
__device__ __forceinline__ int perm32(int rho) { const int n = rho >> 4, i = rho & 15; return 8 * (i >> 2) + 4 * n + (i & 3); }
__device__ __forceinline__ int xcd_remap(int L, int nwg) { const int q = nwg >> 3, r = nwg & 7, xcd = L & 7, off = L >> 3; return (xcd < r ? xcd * (q + 1) : r * (q + 1) + (xcd - r) * q) + off; }

struct GUnit { const char* A; const char* B; int pm, pn, aux, rowbase; };

template <class Epi, class Sched>
__device__ __forceinline__ void gemm_phase(LAS unsigned char* lds, const int K, const Sched& S, const Epi& E) {
    const int tid = opaque_v((int)threadIdx.x), wid = __builtin_amdgcn_readfirstlane(tid >> 6), lane = tid & 63, wr = wid >> 2, wc = wid & 3, fr = lane & 15, fq = lane >> 4;
    const int nt = K / BK;
    int sR[2], sC[2]; unsigned voffB[2];
#pragma unroll
    for (int i = 0; i < 2; ++i) { int R, C; stage_rc(tid * 16 + i * 8192, R, C); const int Rb = Epi::PERM ? ((R & ~31) + perm32(R & 31)) : R; sR[i] = R; sC[i] = C; voffB[i] = (unsigned)(Rb * K + C) * 2u; }
    const size_t kstep = (size_t)(BK * 2);
    const size_t hstep = (size_t)HALF * K * 2;
    const unsigned ldsw = (unsigned)wid * 1024u;
    const int aoff = lds_byte(wr * 64 + fr, fq * 8), boff = lds_byte(wc * 32 + fr, fq * 8);
#define PG8_SA(b, h) (((b) * 2 + (h)) * HTB)
#define PG8_SB(b, h) ((4 + (b) * 2 + (h)) * HTB)
#define PG8_STAGE(bufoff, gbase, v0, v1) do { \
        __builtin_amdgcn_global_load_lds((const unsigned*)((const char*)(gbase) + (v0)), (LAS unsigned*)(lds + (bufoff) + ldsw), 16, 0, 0); \
        __builtin_amdgcn_global_load_lds((const unsigned*)((const char*)(gbase) + (v1)), (LAS unsigned*)(lds + (bufoff) + ldsw + 8192), 16, 0, 0); } while (0)
#define PG8_STAGE_B(bufoff, gbase) PG8_STAGE(bufoff, gbase, voffB[0], voffB[1])
#define PG8_LDA(dst, b, h) do { _Pragma("unroll") for (int m = 0; m < 4; ++m) _Pragma("unroll") for (int k = 0; k < 2; ++k) dst[m][k] = *(const LAS bf16x8*)(lds + PG8_SA(b, h) + aoff + m * 2048 + k * 1024); } while (0)
#define PG8_LDB(dst, b, h) do { _Pragma("unroll") for (int n = 0; n < 2; ++n) _Pragma("unroll") for (int k = 0; k < 2; ++k) dst[n][k] = *(const LAS bf16x8*)(lds + PG8_SB(b, h) + boff + n * 2048 + k * 1024); } while (0)
#define PG8_MMA(ai, bj, At, Bt) do { __builtin_amdgcn_s_setprio(1); _Pragma("unroll") for (int m = 0; m < 4; ++m) _Pragma("unroll") for (int n = 0; n < 2; ++n) { \
        if constexpr (Epi::FP8) { typedef int v4i_ __attribute__((ext_vector_type(4))); typedef int v8i_ __attribute__((ext_vector_type(8))); \
            const v8i_ wf = __builtin_shufflevector(__builtin_bit_cast(v4i_, Bt[n][0]), __builtin_bit_cast(v4i_, Bt[n][1]), 0, 1, 2, 3, 4, 5, 6, 7); \
            const v8i_ af = __builtin_shufflevector(__builtin_bit_cast(v4i_, At[m][0]), __builtin_bit_cast(v4i_, At[m][1]), 0, 1, 2, 3, 4, 5, 6, 7); \
            asm volatile("v_mfma_scale_f32_16x16x128_f8f6f4 %0, %1, %2, %0, %3, %4 op_sel_hi:[0,0,0]" : "+v"(acc[ai][bj][m][n]) : "v"(wf), "v"(af), "v"(scl_w), "v"(scl_a)); \
        } else { _Pragma("unroll") for (int k = 0; k < 2; ++k) acc[ai][bj][m][n] = __builtin_amdgcn_mfma_f32_16x16x32_bf16(Bt[n][k], At[m][k], acc[ai][bj][m][n], 0, 0, 0); } } \
        __builtin_amdgcn_s_setprio(0); } while (0)
#define PG8_WAIT_V(n) asm volatile("s_waitcnt vmcnt(" #n ")" ::: "memory")
#define PG8_WAIT_L(n) asm volatile("s_waitcnt lgkmcnt(" #n ")" ::: "memory")
#define PG8_BAR __builtin_amdgcn_s_barrier()
#define PG8_SCHED __builtin_amdgcn_sched_barrier(0)
    GUnit cur, nxt; int ui = 0;
    if (!S.next(0, cur)) return;
    const int scl_w = 0x79797979, scl_a = 0x7f7f7f7f;
    (void)scl_w; (void)scl_a;
    f32x4 acc[2][2][4][2];
#pragma unroll
    for (int a = 0; a < 2; ++a)
#pragma unroll
        for (int b = 0; b < 2; ++b)
#pragma unroll
            for (int m = 0; m < 4; ++m)
#pragma unroll
                for (int n = 0; n < 2; ++n) acc[a][b][m][n] = (f32x4){0.f, 0.f, 0.f, 0.f};
    bf16x8 At[4][2], B0[2][2], B1[2][2];
    unsigned vA00, vA01, vA10, vA11, vN00 = 0, vN01 = 0, vN10 = 0, vN11 = 0;
    vA00 = S.a_off(cur, sR[0], sC[0]); vA01 = S.a_off(cur, sR[1], sC[1]);
    if constexpr (Sched::GATHER) { vA10 = S.a_off(cur, HALF + sR[0], sC[0]); vA11 = S.a_off(cur, HALF + sR[1], sC[1]); } else { vA10 = vA00; vA11 = vA01; }
    const size_t hA = Sched::GATHER ? (size_t)0 : S.a_hstep();
    const char* cA = cur.A; const char* cB = cur.B;
    PG8_STAGE_B(PG8_SB(0, 0), cB); PG8_STAGE_B(PG8_SB(0, 1), cB + hstep); PG8_STAGE(PG8_SA(0, 0), cA, vA00, vA01); PG8_STAGE(PG8_SA(0, 1), cA + hA, vA10, vA11);
    if (wr == 1) PG8_BAR;
    PG8_WAIT_V(2); PG8_BAR;
    PG8_STAGE_B(PG8_SB(1, 0), cB + kstep); PG8_STAGE(PG8_SA(1, 0), cA + kstep, vA00, vA01); PG8_STAGE_B(PG8_SB(1, 1), cB + hstep + kstep);
    PG8_WAIT_V(6); PG8_BAR;
    for (;;) {
        const bool has_next = S.next(ui + 1, nxt);
        const char* nA = has_next ? nxt.A : cA; const char* nB = has_next ? nxt.B : cB;
        if constexpr (Sched::GATHER) { vN00 = vA00; vN01 = vA01; vN10 = vA10; vN11 = vA11;
            if (has_next) { vN00 = S.a_off(nxt, sR[0], sC[0]); vN01 = S.a_off(nxt, sR[1], sC[1]); vN10 = S.a_off(nxt, HALF + sR[0], sC[0]); vN11 = S.a_off(nxt, HALF + sR[1], sC[1]); } }
        for (int t = 0; t < nt; t += 2) {
            const bool last = (t == nt - 2);
            const char* a1 = cA + (size_t)(t + 1) * kstep;
            const char* a2 = last ? nA : cA + (size_t)(t + 2) * kstep; const char* b2 = last ? nB : cB + (size_t)(t + 2) * kstep;
            const char* a3 = a2 + kstep; const char* b3 = b2 + kstep;
            PG8_LDB(B0, 0, 0); PG8_LDB(B1, 0, 1); PG8_SCHED; PG8_LDA(At, 0, 0); PG8_STAGE(PG8_SA(1, 1), a1 + hA, vA10, vA11);
            if constexpr (Sched::GATHER) { if (last) { vA00 = vN00; vA01 = vN01; vA10 = vN10; vA11 = vN11; } }
            PG8_WAIT_V(8); PG8_WAIT_L(0); PG8_BAR; PG8_MMA(0, 0, At, B0); PG8_MMA(0, 1, At, B1); PG8_BAR; PG8_SCHED;
            PG8_LDA(At, 0, 1); PG8_STAGE_B(PG8_SB(0, 0), b2); PG8_STAGE_B(PG8_SB(0, 1), b2 + hstep); PG8_STAGE(PG8_SA(0, 0), a2, vA00, vA01);
            PG8_WAIT_V(8); PG8_WAIT_L(0); PG8_BAR; PG8_MMA(1, 0, At, B0); PG8_MMA(1, 1, At, B1); PG8_BAR; PG8_SCHED;
            PG8_LDB(B0, 1, 0); PG8_LDB(B1, 1, 1); PG8_SCHED; PG8_LDA(At, 1, 0); PG8_STAGE(PG8_SA(0, 1), a2 + hA, vA10, vA11);
            PG8_WAIT_V(8); PG8_WAIT_L(0); PG8_BAR; PG8_MMA(0, 0, At, B0); PG8_MMA(0, 1, At, B1); PG8_BAR; PG8_SCHED;
            PG8_LDA(At, 1, 1); PG8_STAGE_B(PG8_SB(1, 0), b3); PG8_STAGE_B(PG8_SB(1, 1), b3 + hstep); PG8_STAGE(PG8_SA(1, 0), a3, vA00, vA01);
            PG8_WAIT_V(8); PG8_WAIT_L(0); PG8_BAR; PG8_MMA(1, 0, At, B0); PG8_MMA(1, 1, At, B1); PG8_BAR; PG8_SCHED;
        }
        if (wr == 0) PG8_BAR;
        if constexpr (Epi::FP8) asm volatile("s_nop 15\n\ts_nop 15" ::: "memory");
        const bool reset = E(acc, cur, wr, wc, fr, fq);
        if (!has_next) break;
        if (reset) {
#pragma unroll
            for (int a = 0; a < 2; ++a)
#pragma unroll
                for (int b = 0; b < 2; ++b)
#pragma unroll
                    for (int m = 0; m < 4; ++m)
#pragma unroll
                        for (int n = 0; n < 2; ++n) acc[a][b][m][n] = (f32x4){0.f, 0.f, 0.f, 0.f};
        }
        cur = nxt; cA = nA; cB = nB; ++ui;
        if (wr == 1) PG8_BAR;
    }
    PG8_WAIT_V(0);
    PG8_BAR;
#undef PG8_SA
#undef PG8_SB
#undef PG8_STAGE
#undef PG8_STAGE_B
#undef PG8_LDA
#undef PG8_LDB
#undef PG8_MMA
#undef PG8_WAIT_V
#undef PG8_WAIT_L
#undef PG8_BAR
#undef PG8_SCHED
}

struct SchedLin {
    static constexpr bool GATHER = false;
    int G, c, nM, nN, nsub; const char* A; const char* B; int lda, K; size_t asub, bsub;
    __device__ __forceinline__ size_t a_hstep() const { return (size_t)HALF * lda * 2; }
    __device__ __forceinline__ bool next(int i, GUnit& u) const {
        const int j = i / nsub, nb = i - j * nsub; const int L = j * G + c; const int nwg = nM * nN; if (L >= nwg) return false;
        const int wg = xcd_remap(L, nwg), nig = 8 * nN, gid = wg / nig, fm = gid * 8, rem = wg - gid * nig, gsz = (nM - fm) < 8 ? (nM - fm) : 8;
        u.pm = fm + rem % gsz; u.pn = rem / gsz; u.aux = nb; u.rowbase = u.pm * BM;
        u.A = A + (size_t)u.pm * BM * lda * 2 + nb * asub; u.B = B + (size_t)u.pn * BM * K * 2 + nb * bsub; return true;
    }
    __device__ __forceinline__ unsigned a_off(const GUnit&, int row, int col) const { return (unsigned)(row * lda + col) * 2u; }
};
struct SchedGU {
    static constexpr bool GATHER = true;
    int G, c; const char* H; const char* W; const int* idx;
    __device__ __forceinline__ size_t a_hstep() const { return 0; }
    __device__ __forceinline__ bool next(int i, GUnit& u) const {
        const int L = i * G + c; if (L >= 1536) return false;
        const int wg = xcd_remap(L, 1536); int e, pm, pn, lb;
        if (wg < 1024) { e = wg >> 6; const int r = wg & 63; pm = r & 7; pn = r >> 3; lb = 16384 + e * 2048; }
        else { const int w2 = wg - 1024; e = w2 >> 5; const int r = w2 & 31; pm = r & 3; pn = r >> 2; lb = e * 1024; }
        u.pm = pm; u.pn = pn; u.aux = e; u.rowbase = lb + pm * BM; u.A = H; u.B = W + ((size_t)e * 2048 + (size_t)pn * BM) * 1024; return true;
    }
    __device__ __forceinline__ unsigned a_off(const GUnit& u, int row, int col) const { return (unsigned)(idx[u.rowbase + row] * 512 + col) * 2u; }
};
struct SchedDown {
    static constexpr bool GATHER = false;
    int G, c; const char* A; const char* W;
    __device__ __forceinline__ size_t a_hstep() const { return (size_t)HALF * 1024; }
    __device__ __forceinline__ bool next(int i, GUnit& u) const {
        const int L = i * G + c; if (L >= 768) return false;
        const int wg = xcd_remap(L, 768); const int pm = wg >> 2, pn = wg & 3; const int e = pm < 64 ? (pm >> 2) : ((pm - 64) >> 3);
        u.pm = pm; u.pn = pn; u.aux = e; u.rowbase = pm * BM; u.A = A + (size_t)pm * BM * 1024; u.B = W + ((size_t)e * 1024 + (size_t)pn * BM) * 1024; return true;
    }
    __device__ __forceinline__ unsigned a_off(const GUnit&, int row, int col) const { return (unsigned)(row * 512 + col) * 2u; }
};

struct EpiWin {
    static constexpr bool PERM = true, FP8 = false; bf16_t* BIG; float* out; int layer;
    __device__ __forceinline__ bool operator()(f32x4 (&acc)[2][2][4][2], const GUnit& u, int wr, int wc, int fr, int fq) const {
        const int pm = u.pm, pn = u.pn;
#pragma unroll
        for (int bj = 0; bj < 2; ++bj) {
            const int col = pn * BM + bj * HALF + wc * 32 + 8 * fq;
            float* sp = nullptr; int spitch = 0, scol = 0;
            if (pm < 32) {
                if (col >= C_NAK && col < C_NAV) { sp = out + O_SNAK; spitch = 512; scol = col - C_NAK; }
                else if (col >= C_NAV && col < C_GQ) { sp = out + O_SNAV; spitch = 512; scol = col - C_NAV; }
                else if (col >= C_GV && col < C_CVB) { sp = out + O_SGV; spitch = 128; scol = col - C_GV; }
            }
#pragma unroll
            for (int ai = 0; ai < 2; ++ai)
#pragma unroll
                for (int m = 0; m < 4; ++m) {
                    const int t = ai * HALF + wr * 64 + m * 16 + fr; const size_t row = (size_t)pm * BM + t;
                    const f32x4 v0 = acc[ai][bj][m][0], v1 = acc[ai][bj][m][1];
                    u32x4 w; w.x = cvt_pk_bf16(v0[0], v0[1]); w.y = cvt_pk_bf16(v0[2], v0[3]); w.z = cvt_pk_bf16(v1[0], v1[1]); w.w = cvt_pk_bf16(v1[2], v1[3]);
                    *(u32x4*)(BIG + row * INW + col) = w;
                    if (sp) { float* o = sp + ((size_t)(pm * 4 + layer) * 256 + t) * spitch + scol; *(f32x4*)o = v0; *(f32x4*)(o + 4) = v1; }
                }
        }
        return true;
    }
};
struct EpiWinGate {
    static constexpr bool PERM = true, FP8 = true; bf16_t* BIG;
    __device__ __forceinline__ bool operator()(f32x4 (&acc)[2][2][4][2], const GUnit& u, int wr, int wc, int fr, int fq) const {
#pragma unroll
        for (int bj = 0; bj < 2; ++bj) {
            const int col = C_F8 + u.pn * BM + bj * HALF + wc * 32 + 8 * fq; const bool gate = col >= C_GATE;
#pragma unroll
            for (int ai = 0; ai < 2; ++ai)
#pragma unroll
                for (int m = 0; m < 4; ++m) {
                    const size_t row = (size_t)u.pm * BM + ai * HALF + wr * 64 + m * 16 + fr;
                    f32x4 v0 = acc[ai][bj][m][0], v1 = acc[ai][bj][m][1];
                    if (gate) {
#pragma unroll
                        for (int j = 0; j < 4; ++j) { v0[j] = fmaxf(sigmoidf_(v0[j]) * 255.0f, 1.0f); v1[j] = fmaxf(sigmoidf_(v1[j]) * 255.0f, 1.0f); }
                        u32x2 w; w.x = pack4_u8(v0[0], v0[1], v0[2], v0[3]); w.y = pack4_u8(v1[0], v1[1], v1[2], v1[3]);
                        *(u32x2*)((unsigned char*)(BIG + row * INW + C_GATE) + (col - C_GATE)) = w;
                    } else { u32x4 w; w.x = cvt_pk_bf16(v0[0], v0[1]); w.y = cvt_pk_bf16(v0[2], v0[3]); w.z = cvt_pk_bf16(v1[0], v1[1]); w.w = cvt_pk_bf16(v1[2], v1[3]);
                        *(u32x4*)(BIG + row * INW + col) = w; }
                }
        }
        return true;
    }
};
struct EpiBranch {
    static constexpr bool PERM = true, FP8 = true; const bf16_t* BIG; bf16_t* MRG;
    __device__ __forceinline__ bool operator()(f32x4 (&acc)[2][2][4][2], const GUnit& u, int wr, int wc, int fr, int fq) const {
        const int nb = u.aux; const bool last = nb == 3; const int dofs = last ? 0 : 1024;
#pragma unroll
        for (int ai = 0; ai < 2; ++ai) {
            const size_t row0 = (size_t)u.pm * BM + ai * HALF + wr * 64 + fr; const int col0 = u.pn * BM + wc * 32 + 8 * fq;
            const unsigned char* gp = (const unsigned char*)(BIG + row0 * INW + C_GATE) + nb * 1024 + col0;
#pragma unroll
            for (int bj = 0; bj < 2; ++bj) {
                u32x2 g0[4], g1[4];
#pragma unroll
                for (int m = 0; m < 4; ++m) { g0[m] = *(const u32x2*)(gp + (size_t)m * 16 * INW * 2 + bj * HALF); g1[m] = *(const u32x2*)(gp + (size_t)m * 16 * INW * 2 + bj * HALF + dofs); }
#pragma unroll
                for (int m = 0; m < 4; ++m) {
                    float s[8], d[8]; u8x8_to_f32(g0[m], s); u8x8_to_f32(g1[m], d);
#pragma unroll
                    for (int j = 0; j < 8; ++j) s[j] = last ? s[j] * (1.0f / 255.0f) : s[j] * __builtin_amdgcn_rcpf(d[j]);
                    f32x4 v0 = acc[ai][bj][m][0], v1 = acc[ai][bj][m][1];
#pragma unroll
                    for (int j = 0; j < 4; ++j) { v0[j] *= s[j]; v1[j] *= s[4 + j]; }
                    acc[ai][bj][m][0] = v0; acc[ai][bj][m][1] = v1;
                    if (last) { u32x4 w; w.x = cvt_pk_bf16(v0[0], v0[1]); w.y = cvt_pk_bf16(v0[2], v0[3]); w.z = cvt_pk_bf16(v1[0], v1[1]); w.w = cvt_pk_bf16(v1[2], v1[3]);
                        *(u32x4*)(MRG + (row0 + m * 16) * D + col0 + bj * HALF) = w; }
                }
                asm volatile("" ::: "memory");
            }
        }
        return last;
    }
};
struct EpiWout {
    static constexpr bool PERM = true, FP8 = false; const bf16_t* x; const float* mod; bf16_t* V;
    __device__ __forceinline__ bool operator()(f32x4 (&acc)[2][2][4][2], const GUnit& u, int wr, int wc, int fr, int fq) const {
        const int mr = u.pm < 32 ? 0 : 1 + ((u.pm - 32) >> 3); const float* g1 = mod + mr * 6144 + 2048;
#pragma unroll
        for (int bj = 0; bj < 2; ++bj) {
            const int col = u.pn * BM + bj * HALF + wc * 32 + 8 * fq; const f32x4 gv0 = *(const f32x4*)(g1 + col), gv1 = *(const f32x4*)(g1 + col + 4);
            const size_t off0 = ((size_t)u.pm * BM + wr * 64 + fr) * D + col;
#pragma unroll
            for (int ai = 0; ai < 2; ++ai) {
                u32x4 xv[4];
#pragma unroll
                for (int m = 0; m < 4; ++m) xv[m] = *(const u32x4*)(x + off0 + (size_t)(ai * HALF + m * 16) * D);
#pragma unroll
                for (int m = 0; m < 4; ++m) { const u32x4 a = xv[m]; const f32x4 x0 = {h16lo(a.x), h16hi(a.x), h16lo(a.y), h16hi(a.y)}, x1 = {h16lo(a.z), h16hi(a.z), h16lo(a.w), h16hi(a.w)};
                    const f32x4 v0 = ALPHA * x0 + gv0 * acc[ai][bj][m][0], v1 = ALPHA * x1 + gv1 * acc[ai][bj][m][1];
                    u32x4 w; w.x = cvt_pk_f16(v0[0], v0[1]); w.y = cvt_pk_f16(v0[2], v0[3]); w.z = cvt_pk_f16(v1[0], v1[1]); w.w = cvt_pk_f16(v1[2], v1[3]);
                    *(u32x4*)(V + off0 + (size_t)(ai * HALF + m * 16) * D) = w; }
                asm volatile("" ::: "memory");
            }
        }
        return true;
    }
};
struct EpiGU {
    static constexpr bool PERM = true, FP8 = true; unsigned char* HDN8;
    __device__ __forceinline__ bool operator()(f32x4 (&acc)[2][2][4][2], const GUnit& u, int wr, int wc, int fr, int fq) const {
#pragma unroll
        for (int ai = 0; ai < 2; ++ai)
#pragma unroll
            for (int m = 0; m < 4; ++m) { const size_t row = (size_t)u.rowbase + ai * HALF + wr * 64 + m * 16 + fr; float h[8];
#pragma unroll
                for (int n = 0; n < 2; ++n)
#pragma unroll
                    for (int j = 0; j < 4; ++j) { const float g = acc[ai][0][m][n][j], up = acc[ai][1][m][n][j]; h[4 * n + j] = g * sigmoidf_(g) * up; }
                u32x2 w; w.x = cvt4_fp8_sat(h[0], h[1], h[2], h[3]); w.y = cvt4_fp8_sat(h[4], h[5], h[6], h[7]);
                *(u32x2*)(HDN8 + row * 1024 + u.pn * HALF + wc * 32 + 8 * fq) = w; }
        return true;
    }
};
struct EpiDown {
    static constexpr bool PERM = true, FP8 = true; unsigned char* YE8;
    __device__ __forceinline__ bool operator()(f32x4 (&acc)[2][2][4][2], const GUnit& u, int wr, int wc, int fr, int fq) const {
#pragma unroll
        for (int ai = 0; ai < 2; ++ai)
#pragma unroll
            for (int m = 0; m < 4; ++m) { const size_t row = (size_t)u.rowbase + ai * HALF + wr * 64 + m * 16 + fr;
#pragma unroll
                for (int bj = 0; bj < 2; ++bj) { const f32x4 v0 = acc[ai][bj][m][0] * 16.0f, v1 = acc[ai][bj][m][1] * 16.0f;
                    u32x2 w; w.x = cvt4_fp8_sat(v0[0], v0[1], v0[2], v0[3]); w.y = cvt4_fp8_sat(v1[0], v1[1], v1[2], v1[3]);
                    *(u32x2*)(YE8 + row * 1024 + u.pn * BM + bj * HALF + wc * 32 + 8 * fq) = w; } }
        return true;
    }
};
}

struct AUnit { int opitch; const bf16_t* q; unsigned char* o; const bf16_t* k0; const bf16_t* v0; const bf16_t* k1; const bf16_t* v1; int pitch0, pitch1, nt0, nt1, na, qrow0, krow0; const float* rpb; };
constexpr int KP = 72;
constexpr int VPB = 192;
constexpr int ATT_KBUF = 64 * KP * 2, ATT_VBUF = 64 * VPB, ATT_K = 0, ATT_V = 2 * ATT_KBUF, ATT_RPB = ATT_V + 2 * ATT_VBUF;
typedef short v4i16_t __attribute__((ext_vector_type(4)));
__device__ __forceinline__ u32x2 vtr(const LAS unsigned char* p) { return __builtin_bit_cast(u32x2, __builtin_amdgcn_ds_read_tr16_b64_v4i16((LAS v4i16_t*)p)); }

template <int VAR, bool NA> __device__ __forceinline__ void attn_unit(LAS unsigned char* lds, const AUnit& u) {
    const int tid = opaque_v((int)threadIdx.x), lane = tid & 63, r32 = lane & 31, hh = lane >> 5; const int wid = __builtin_amdgcn_readfirstlane(tid >> 6);
    LAS float* rpbS = (LAS float*)(lds + ATT_RPB);
    bf16x8 qf[4];
    { const bf16_t* qp = u.q + (size_t)(wid * 32 + r32) * INW + hh * 8;
#pragma unroll
      for (int ks = 0; ks < 4; ++ks) qf[ks] = *(const bf16x8*)(qp + ks * 16); }
    if (NA) for (int i = tid; i < 465; i += 512) rpbS[i] = u.rpb[i];
    asm volatile("" :: "v"(qf[0]), "v"(qf[1]), "v"(qf[2]), "v"(qf[3]));
    const int skey = tid >> 3, sch = tid & 7, NT = u.nt0 + u.nt1;
    u32x4 kA, vA, kB, vB;
#define ATT_LOAD(t, KR, VR) do { if (VAR & 4) break; const bf16_t *kp_, *vp_; if ((t) < u.nt0) { const size_t o_ = (size_t)((t) * 64 + skey) * u.pitch0 + sch * 8; kp_ = u.k0 + o_; vp_ = u.v0 + o_; } \
        else { const size_t o_ = (size_t)(((t) - u.nt0) * 64 + skey) * u.pitch1 + sch * 8; kp_ = u.k1 + o_; vp_ = u.v1 + o_; } KR = *(const u32x4*)kp_; VR = *(const u32x4*)vp_; } while (0)
#define ATT_WRITE(b, KR, VR) do { if (VAR & 4) break; *(LAS u32x4*)(lds + ATT_K + (b) * ATT_KBUF + skey * (KP * 2) + sch * 16) = KR; *(LAS u32x4*)(lds + ATT_V + (b) * ATT_VBUF + skey * VPB + sch * 16) = VR; } while (0)
#define ATT_SYNC() do { asm volatile("s_waitcnt lgkmcnt(0)" ::: "memory"); if (!(VAR & 16)) __builtin_amdgcn_s_barrier(); asm volatile("" ::: "memory"); } while (0)
    ATT_LOAD(0, kA, vA); if (NT > 1) ATT_LOAD(1, kB, vB);
    ATT_WRITE(0, kA, vA);
    ATT_SYNC();
    float mrun = -1e30f, lrun = 0.f; f32x16 o0 = {}, o1 = {};
    const int qr = u.qrow0 + (wid >> 1), qc = 32 * (wid & 1) + r32;
    const int rs = min(max(qr - 4, 0), 24), cs = min(max(qc - 8, 0), 48);
    const int vtoff = (4 * hh + ((lane & 15) >> 2)) * VPB + (16 * ((lane >> 4) & 1) + 4 * (lane & 3)) * 2;
#define ATT_COMPUTE(t) do { \
        const bool local = NA && (t) < u.nt0; const int krow = u.krow0 + (t); \
        const bool active = !local || (krow >= rs && krow < rs + 8); \
        if (active) { \
            const LAS unsigned char* Kb = lds + ATT_K + ((t) & 1) * ATT_KBUF; const LAS unsigned char* Vb = lds + ATT_V + ((t) & 1) * ATT_VBUF + vtoff; \
            f32x16 p0 = {}, p1 = {}; \
            _Pragma("unroll") for (int ks = 0; ks < 4; ++ks) { \
                const bf16x8 a0 = *(const LAS bf16x8*)(Kb + r32 * (KP * 2) + (ks * 16 + hh * 8) * 2); \
                const bf16x8 a1 = *(const LAS bf16x8*)(Kb + (32 + r32) * (KP * 2) + (ks * 16 + hh * 8) * 2); \
                if (VAR & 8) { p0[ks] += __builtin_bit_cast(f32x4, a0)[0]; p1[ks] += __builtin_bit_cast(f32x4, a1)[1]; } else { \
                p0 = __builtin_amdgcn_mfma_f32_32x32x16_bf16(a0, qf[ks], p0, 0, 0, 0); \
                p1 = __builtin_amdgcn_mfma_f32_32x32x16_bf16(a1, qf[ks], p1, 0, 0, 0); } } \
            if (!(VAR & 2)) { float rsum; \
              if (local) { \
                const LAS float* br = rpbS + (krow - qr + 7) * 31 + (15 - qc); \
                _Pragma("unroll") for (int i = 0; i < 16; ++i) { const int kc = (i & 3) + 8 * (i >> 2) + 4 * hh; \
                    { const bool ok = kc >= cs && kc < cs + 16; const float b = ok ? br[kc] : 0.f; p0[i] = ok ? p0[i] * C2 + b * LOG2E : -INFINITY; } \
                    { const int kc1 = kc + 32; const bool ok = kc1 >= cs && kc1 < cs + 16; const float b = ok ? br[kc1] : 0.f; p1[i] = ok ? p1[i] * C2 + b * LOG2E : -INFINITY; } } \
                float mt = __builtin_fmaxf(p0[0], p1[0]); \
                _Pragma("unroll") for (int i = 1; i < 16; ++i) mt = __builtin_fmaxf(__builtin_fmaxf(mt, p0[i]), p1[i]); \
                mt = fmaxf(mt, __shfl_xor(mt, 32)); \
                if (__any(mt > mrun + 8.0f)) { const float mn = fmaxf(mrun, mt), al = fast_exp2(mrun - mn); mrun = mn; lrun *= al; \
                    _Pragma("unroll") for (int i = 0; i < 16; ++i) { o0[i] *= al; o1[i] *= al; } } \
                _Pragma("unroll") for (int i = 0; i < 16; ++i) { p0[i] = fast_exp2(p0[i] - mrun); p1[i] = fast_exp2(p1[i] - mrun); } \
              } else { \
                float mt = __builtin_fmaxf(p0[0], p1[0]); \
                _Pragma("unroll") for (int i = 1; i < 16; ++i) mt = __builtin_fmaxf(__builtin_fmaxf(mt, p0[i]), p1[i]); \
                mt = fmaxf(mt, __shfl_xor(mt, 32)) * C2; \
                if (__any(mt > mrun + 8.0f)) {                   \
                    const float mn = fmaxf(mrun, mt), al = fast_exp2(mrun - mn); mrun = mn; lrun *= al; \
                    _Pragma("unroll") for (int i = 0; i < 16; ++i) { o0[i] *= al; o1[i] *= al; } } \
                const float nm = -mrun; \
                _Pragma("unroll") for (int i = 0; i < 16; ++i) { p0[i] = fast_exp2(__builtin_fmaf(p0[i], C2, nm)); p1[i] = fast_exp2(__builtin_fmaf(p1[i], C2, nm)); } \
              } \
              { typedef float f32x2_ __attribute__((ext_vector_type(2))); f32x2_ sa = {p0[0], p0[1]}, sb = {p1[0], p1[1]}; \
                _Pragma("unroll") for (int i = 2; i < 16; i += 2) { sa += (f32x2_){p0[i], p0[i + 1]}; sb += (f32x2_){p1[i], p1[i + 1]}; } \
                sa += sb; rsum = sa[0] + sa[1]; } \
              lrun += rsum; } \
            bf16x8 pf[4]; \
            _Pragma("unroll") for (int s = 0; s < 2; ++s) { \
                u32x4 w; w.x = cvt_pk_bf16(p0[8 * s + 0], p0[8 * s + 1]); w.y = cvt_pk_bf16(p0[8 * s + 2], p0[8 * s + 3]); w.z = cvt_pk_bf16(p0[8 * s + 4], p0[8 * s + 5]); w.w = cvt_pk_bf16(p0[8 * s + 6], p0[8 * s + 7]); \
                pf[s] = __builtin_bit_cast(bf16x8, w); \
                u32x4 x; x.x = cvt_pk_bf16(p1[8 * s + 0], p1[8 * s + 1]); x.y = cvt_pk_bf16(p1[8 * s + 2], p1[8 * s + 3]); x.z = cvt_pk_bf16(p1[8 * s + 4], p1[8 * s + 5]); x.w = cvt_pk_bf16(p1[8 * s + 6], p1[8 * s + 7]); \
                pf[2 + s] = __builtin_bit_cast(bf16x8, x); } \
            _Pragma("unroll") for (int s = 0; s < 4; ++s) { \
                const LAS unsigned char* vp = Vb + 16 * s * VPB; \
                { const u32x2 lo = vtr(vp), hi = vtr(vp + 8 * VPB); const u32x4 w = {lo.x, lo.y, hi.x, hi.y}; \
                  if (VAR & 8) o0[s] += __builtin_bit_cast(f32x4, w)[0] * __builtin_bit_cast(f32x4, pf[s])[1]; else o0 = __builtin_amdgcn_mfma_f32_32x32x16_bf16(__builtin_bit_cast(bf16x8, w), pf[s], o0, 0, 0, 0); } \
                { const u32x2 lo = vtr(vp + 64), hi = vtr(vp + 8 * VPB + 64); const u32x4 w = {lo.x, lo.y, hi.x, hi.y}; \
                  if (VAR & 8) o1[s] += __builtin_bit_cast(f32x4, w)[2] * __builtin_bit_cast(f32x4, pf[s])[3]; else o1 = __builtin_amdgcn_mfma_f32_32x32x16_bf16(__builtin_bit_cast(bf16x8, w), pf[s], o1, 0, 0, 0); } } \
        } } while (0)
    for (int t = 0; t < NT; t += 2) {
        if (t + 2 < NT) ATT_LOAD(t + 2, kA, vA);
        ATT_COMPUTE(t);
        if (t + 1 < NT) ATT_WRITE(1, kB, vB);
        ATT_SYNC();
        if (t + 1 >= NT) break;
        if (t + 3 < NT) ATT_LOAD(t + 3, kB, vB);
        ATT_COMPUTE(t + 1);
        if (t + 2 < NT) ATT_WRITE(0, kA, vA);
        ATT_SYNC();
    }
    const float ltot = lrun + __shfl_xor(lrun, 32), inv = 1.0f / ltot;
    unsigned char* op = u.o + (size_t)(wid * 32 + r32) * u.opitch + 4 * hh;
#pragma unroll
    for (int g = 0; g < 4; ++g) {
        *(unsigned*)(op + 8 * g) = cvt4_fp8(o0[4 * g] * inv, o0[4 * g + 1] * inv, o0[4 * g + 2] * inv, o0[4 * g + 3] * inv);
        *(unsigned*)(op + 32 + 8 * g) = cvt4_fp8(o1[4 * g] * inv, o1[4 * g + 1] * inv, o1[4 * g + 2] * inv, o1[4 * g + 3] * inv);
    }
#undef ATT_LOAD
#undef ATT_WRITE
#undef ATT_SYNC
#undef ATT_COMPUTE
}

template <int VAR> __device__ __forceinline__ void ph_attention(const Args& a, int l, LAS unsigned char* lds, int G, int bx) {
    const bf16_t* BIG = (const bf16_t*)(a.ws + WS_BIG); unsigned char* BR = VAR ? a.ws + WS_H : a.ws + WS_BR; const int BRW_ = VAR ? 1024 : BRW;
    for (int i = 0;; ++i) {
        const int au = i * G + bx; if (au >= 1536) break;
        AUnit u; u.k1 = nullptr; u.v1 = nullptr; u.pitch1 = 0; u.nt1 = 0; u.na = 0; u.qrow0 = 0; u.krow0 = 0; u.rpb = nullptr; u.pitch0 = INW;
        if (au < 512) {
            const int b = au >> 6, h = (au >> 3) & 7, qb = au & 7; const size_t rq = (size_t)NCTX + b * 2048 + qb * 256, rk = (size_t)NCTX + b * 2048;
            u.q = BIG + rq * INW + C_GQ + h * 64; u.o = BR + rq * BRW_ + 512 + h * 64;
            u.k0 = BIG + rk * INW + C_GK + (h >> 2) * 64; u.v0 = BIG + rk * INW + C_GV + (h >> 2) * 64; u.nt0 = 32;
            const size_t co = (size_t)((b * 4 + l) * 512) * 128 + (h >> 2) * 64;
            u.k1 = (const bf16_t*)(a.ws + WS_CGK) + co; u.v1 = (const bf16_t*)(a.ws + WS_CGV) + co; u.pitch1 = 128; u.nt1 = 8;
        } else if (au < 1024) {
            const int a2 = au - 512, b = a2 >> 6, h = (a2 >> 3) & 7, rq4 = a2 & 7; const size_t rq = (size_t)NCTX + b * 2048 + rq4 * 256;
            u.q = BIG + rq * INW + C_NAQ + h * 64; u.o = BR + rq * BRW_ + h * 64;
            u.qrow0 = 4 * rq4; u.krow0 = min(max(4 * rq4 - 4, 0), 24); const int kend = min(max(4 * rq4 - 1, 0), 24) + 8; u.nt0 = kend - u.krow0;
            const size_t rk = (size_t)NCTX + b * 2048 + u.krow0 * 64;
            u.k0 = BIG + rk * INW + C_NAK + h * 64; u.v0 = BIG + rk * INW + C_NAV + h * 64;
            const size_t co = (size_t)((b * 4 + l) * 512) * 512 + h * 64;
            u.k1 = (const bf16_t*)(a.ws + WS_CNAK) + co; u.v1 = (const bf16_t*)(a.ws + WS_CNAV) + co; u.pitch1 = 512; u.nt1 = 8;
            u.na = 1; u.rpb = a.in[I_RPB] + (size_t)(l * 8 + h) * 465;
        } else {
            const int a3 = au - 1024, kind = a3 >> 8, b = (a3 & 255) >> 3, h = a3 & 7; const size_t rq = (size_t)b * 256;
            if (kind == 0) { u.q = BIG + rq * INW + C_NAQ + h * 64; u.k0 = BIG + rq * INW + C_NAK + h * 64; u.v0 = BIG + rq * INW + C_NAV + h * 64; u.o = BR + rq * BRW_ + h * 64; }
            else { u.q = BIG + rq * INW + C_GQ + h * 64; u.k0 = BIG + rq * INW + C_GK + (h >> 2) * 64; u.v0 = BIG + rq * INW + C_GV + (h >> 2) * 64; u.o = BR + rq * BRW_ + 512 + h * 64; }
            u.nt0 = 4;
        }
        u.opitch = BRW_; if (u.na) attn_unit<VAR, true>(lds, u); else attn_unit<VAR, false>(lds, u);
    }
}

__device__ __forceinline__ void transpose_item(const float* W, int K, int N, void* WT, int mode, LAS float* scr, int item, int lane, bool fp8 = false, int ncols = 0) {
    const int nblk = (ncols ? ncols : N) >> 5, kb = item / nblk, nb = item - kb * nblk, k0 = kb << 6, n0 = nb << 5;
#pragma unroll 8
    for (int i = 0; i < 32; ++i) { const int kk = 2 * i + (lane >> 5); scr[kk * 33 + (lane & 31)] = W[(size_t)(k0 + kk) * N + n0 + (lane & 31)]; }
    LDS_WAIT();
    const int c = lane & 7;
#pragma unroll
    for (int j = 0; j < 4; ++j) { const int n = (lane >> 3) + 8 * j, nn = n0 + n; const int orow = mode == 0 ? nn : (((nn >> 7) << 8) + (nn & 127) + (mode == 2 ? 128 : 0));
        const LAS float* s = scr + (8 * c) * 33 + n;
        if (fp8) { u32x2 o; o.x = cvt4_fp8_sat(s[0 * 33] * W8_SCALE, s[1 * 33] * W8_SCALE, s[2 * 33] * W8_SCALE, s[3 * 33] * W8_SCALE); o.y = cvt4_fp8_sat(s[4 * 33] * W8_SCALE, s[5 * 33] * W8_SCALE, s[6 * 33] * W8_SCALE, s[7 * 33] * W8_SCALE);
            *(u32x2*)((unsigned char*)WT + (size_t)orow * K + k0 + 8 * c) = o; }
        else { u32x4 o; o.x = cvt_pk_bf16(s[0 * 33], s[1 * 33]); o.y = cvt_pk_bf16(s[2 * 33], s[3 * 33]); o.z = cvt_pk_bf16(s[4 * 33], s[5 * 33]); o.w = cvt_pk_bf16(s[6 * 33], s[7 * 33]);
            *(u32x4*)((bf16_t*)WT + (size_t)orow * K + k0 + 8 * c) = o; } }
    LDS_WAIT();
}
constexpr int NI_WINB = 16 * (C_F8 / 32), NI_WIN8 = 16 * (NF8 / 32), NI_WIN = NI_WINB + NI_WIN8, NI_BR = 3 * 256, NI_WO = 512, NI_E = 16 * 512, LAYER_ITEMS = NI_WIN + NI_BR + NI_WO + 3 * NI_E;
constexpr int NT_ITEMS = DEPTH * LAYER_ITEMS, NF_ITEMS = 1024, NC_ITEMS = 40960, P0_ITEMS = NT_ITEMS + NF_ITEMS + NC_ITEMS;

__device__ __forceinline__ void ph_prologue(const Args& a, LAS unsigned char* lds, int G, int bx, int tid, int wave, int lane) {
    { const int gt = bx * 512 + tid;
      if (gt < 1024) { const int pos = gt >> 4, f = gt & 15; const double invd = exp10(-(double)f * 0.25);
          const float ang = (float)pos * (float)invd; const double x = (double)ang;
          const double k = rint(x * 0.15915494309189535); const double r = fma(-k, 6.283185307179586, x) - k * 2.4492935982947064e-16;
          const double r2 = r * r; double ts = r, ss = r, tc = 1.0, sc = 1.0;
          for (int q = 1; q <= 14; ++q) { ts *= -r2 / (double)((2 * q) * (2 * q + 1)); ss += ts; tc *= -r2 / (double)((2 * q - 1) * (2 * q)); sc += tc; }
          float* rt = (float*)(a.ws + WS_ROPE); rt[2 * gt] = (float)sc; rt[2 * gt + 1] = (float)ss; } }
    if (bx < 384) {
        LAS float* sil = (LAS float*)lds; LAS float* part = (LAS float*)(lds + 36864);
        for (int i = tid; i < 9 * 1024; i += 512) { const int r = i >> 10, d = i & 1023; const float cv = r == 0 ? a.in[I_CCTX][d] : a.in[I_C][(r - 1) * 1024 + d]; sil[i] = cv * sigmoidf_(cv); }
        __syncthreads();
        for (int it = bx; it < 384; it += G) { const int l = it / 96, cg = it - l * 96;
            float acc[9];
#pragma unroll
            for (int r = 0; r < 9; ++r) acc[r] = 0.f;
            const float* wp = a.in[I_WADA] + ((size_t)l * 1024 + wave * 128) * 6144 + cg * 64 + lane;
#pragma unroll 8
            for (int d = 0; d < 128; ++d) { const float wv = wp[(size_t)d * 6144];
#pragma unroll
                for (int r = 0; r < 9; ++r) acc[r] += sil[r * 1024 + wave * 128 + d] * wv; }
#pragma unroll
            for (int r = 0; r < 9; ++r) part[(wave * 9 + r) * 64 + lane] = acc[r];
            __syncthreads();
            for (int i = tid; i < 576; i += 512) { const int r = i >> 6, col = i & 63; float s = a.in[I_BADA][l * 6144 + cg * 64 + col];
#pragma unroll
                for (int w = 0; w < 8; ++w) s += part[(w * 9 + r) * 64 + col];
                ((float*)(a.ws + WS_MOD))[(size_t)(l * 9 + r) * 6144 + cg * 64 + col] = s; }
            __syncthreads();
        }
    }
    __syncthreads();
    LAS float* scr = (LAS float*)(lds + wave * 16384);
    const int gw = bx * 8 + wave, NGW = G * 8;
    for (int it = gw; it < P0_ITEMS; it += NGW) {
        if (it < NT_ITEMS) {
            const int l = it / LAYER_ITEMS; int r = it - l * LAYER_ITEMS;
            if (r < NI_WINB) { transpose_item(a.in[I_WIN] + (size_t)l * 1024 * INW, 1024, INW, (bf16_t*)(a.ws + WS_WI) + (size_t)l * INW * 1024, 0, scr, r, lane, false, C_F8); continue; } r -= NI_WINB;
            if (r < NI_WIN8) { transpose_item(a.in[I_WIN] + (size_t)l * 1024 * INW + C_F8, 1024, INW, a.ws + WS_WI8 + (size_t)l * NF8 * 1024, 0, scr, r, lane, true, NF8); continue; } r -= NI_WIN8;
            if (r < NI_BR) { const int n = r >> 8; transpose_item(a.in[I_WBR] + (size_t)(l * 4 + n) * 512 * 1024, 512, 1024, a.ws + WS_WBR + (size_t)(l * 4 + n) * 1024 * 512, 0, scr, r & 255, lane, true); continue; } r -= NI_BR;
            if (r < NI_WO) { transpose_item(a.in[I_WOUT] + (size_t)l * 1024 * 1024, 1024, 1024, (bf16_t*)(a.ws + WS_WO) + (size_t)l * 1024 * 1024, 0, scr, r, lane); continue; } r -= NI_WO;
            const int which = r / NI_E; r -= which * NI_E; const int e = r >> 9; r &= 511; const size_t le = (size_t)(l * 16 + e);
            if (which == 0) transpose_item(a.in[I_WG] + le * 1048576, 1024, 1024, a.ws + WS_WGU8 + le * 2097152, 1, scr, r, lane, true);
            else if (which == 1) transpose_item(a.in[I_WU] + le * 1048576, 1024, 1024, a.ws + WS_WGU8 + le * 2097152, 2, scr, r, lane, true);
            else transpose_item(a.in[I_WDN] + le * 1048576, 1024, 1024, a.ws + WS_WD8 + le * 1048576, 0, scr, r, lane, true);
        } else if (it < NT_ITEMS + NF_ITEMS) {
            const int r = it - NT_ITEMS, l = r >> 8, g = (r >> 6) & 3, cb = (r >> 4) & 3, db = r & 15, c0 = cb * 32, d0 = db * 64;
            const float* pw = a.in[I_POOLW] + ((size_t)(l * 4 + g) * 128 + c0) * 128;
#pragma unroll 8
            for (int q = 0; q < 64; ++q) scr[lane + 64 * q] = pw[lane + 64 * q];
            LDS_WAIT();
            float acc[32];
#pragma unroll
            for (int ci = 0; ci < 32; ++ci) acc[ci] = 0.f;
            const float* wb = a.in[I_WBR] + ((size_t)(l * 4 + 3) * 512 + g * 128) * 1024 + d0 + lane; const float* ps = a.in[I_POOLS] + l * 512 + g * 128;
            for (int j = 0; j < 128; ++j) { const float wv = wb[(size_t)j * 1024] * ps[j];
#pragma unroll
                for (int ci = 0; ci < 32; ++ci) acc[ci] += scr[ci * 128 + j] * wv; }
            unsigned char* o = a.ws + WS_WBR + ((size_t)(l * 4 + 3) * 1024 + d0 + lane) * 512 + g * 128 + c0;
#pragma unroll
            for (int q = 0; q < 4; ++q) { u32x2 w; w.x = cvt4_fp8_sat(acc[8 * q] * W8_SCALE, acc[8 * q + 1] * W8_SCALE, acc[8 * q + 2] * W8_SCALE, acc[8 * q + 3] * W8_SCALE); w.y = cvt4_fp8_sat(acc[8 * q + 4] * W8_SCALE, acc[8 * q + 5] * W8_SCALE, acc[8 * q + 6] * W8_SCALE, acc[8 * q + 7] * W8_SCALE);
                *(u32x2*)(o + 8 * q) = w; }
            LDS_WAIT();
        } else {
            int r = it - NT_ITEMS - NF_ITEMS; const float* src; bf16_t* dst;
            if (r < 16384) { src = a.in[I_CNAK]; dst = (bf16_t*)(a.ws + WS_CNAK); }
            else if (r < 32768) { r -= 16384; src = a.in[I_CNAV]; dst = (bf16_t*)(a.ws + WS_CNAV); }
            else if (r < 36864) { r -= 32768; src = a.in[I_CGK]; dst = (bf16_t*)(a.ws + WS_CGK); }
            else { r -= 36864; src = a.in[I_CGV]; dst = (bf16_t*)(a.ws + WS_CGV); }
            const size_t e0 = (size_t)r * 512 + lane * 8; const f32x4 x0 = *(const f32x4*)(src + e0), x1 = *(const f32x4*)(src + e0 + 4);
            u32x4 w; w.x = cvt_pk_bf16(x0[0], x0[1]); w.y = cvt_pk_bf16(x0[2], x0[3]); w.z = cvt_pk_bf16(x1[0], x1[1]); w.w = cvt_pk_bf16(x1[2], x1[3]);
            *(u32x4*)(dst + e0) = w;
        }
    }
}

__device__ __forceinline__ float sum16(float v) { v += __shfl_xor(v, 1); v += __shfl_xor(v, 2); v += __shfl_xor(v, 4); v += __shfl_xor(v, 8); return v; }
__device__ __forceinline__ float sum32(float v) { v = sum16(v); v += __shfl_xor(v, 16); return v; }
__device__ __forceinline__ void ph_x(const Args& a, int l, int gw, int NGW, int lane) {
    const float* mod = (const float*)(a.ws + WS_MOD); bf16_t* H = (bf16_t*)(a.ws + WS_H);
    const int* slot = (const int*)(a.ws + WS_SLOT); const float* aff = (const float*)(a.ws + WS_AFF); const unsigned char* YE = a.ws + WS_YE;
    const int s = lane & 31, r = lane >> 5;
    for (int t0 = gw * 2; t0 < NTOK; t0 += NGW * 2) {
        const int tok = t0 + r, mr = modrow_of_tok(tok); float* xo = a.out + (size_t)tok * D + 8 * s; bf16_t* xb = (bf16_t*)(a.ws + WS_XB) + (size_t)tok * D + 8 * s; f32x4 x[8];
        if (l == 0) { const float* xi = (tok < NCTX ? a.in[I_XP] + (size_t)tok * D : a.in[I_XS] + (size_t)(tok - NCTX) * D) + 8 * s;
#pragma unroll
            for (int c = 0; c < 4; ++c) { x[2 * c] = *(const f32x4*)(xi + 256 * c); x[2 * c + 1] = *(const f32x4*)(xi + 256 * c + 4); }
        } else {
#pragma unroll
            for (int c = 0; c < 4; ++c) { const u32x4 w = *(const u32x4*)(xb + 256 * c); x[2 * c] = (f32x4){h16lo(w.x), h16hi(w.x), h16lo(w.y), h16hi(w.y)}; x[2 * c + 1] = (f32x4){h16lo(w.z), h16hi(w.z), h16lo(w.w), h16hi(w.w)}; }
            f32x4 acc[8];
#pragma unroll
            for (int j = 0; j < 8; ++j) acc[j] = (f32x4){0.f, 0.f, 0.f, 0.f};
            int sl = -1; float af = 0.f; if (s < 16) { sl = slot[(size_t)s * NTOK + tok]; af = aff[tok * 16 + s]; }
            unsigned m = (unsigned)(__ballot(sl >= 0) >> (32 * r)) & 0xffffu;
            const int ebase = tok < NCTX ? 0 : 16384, ecap = tok < NCTX ? 1024 : 2048;
            while (__any(m != 0u)) {
                const bool valid = m != 0u; const int e = valid ? __builtin_ctz(m) : 0; m &= m - 1u;
                const int si = __shfl(sl, (lane & 32) + e); const float g = valid ? __shfl(af, (lane & 32) + e) * (1.0f / 16.0f) : 0.f;
                const unsigned char* yr = YE + (size_t)(ebase + e * ecap + (valid ? si : 0)) * D + 8 * s;
#pragma unroll
                for (int c = 0; c < 4; ++c) { const u32x2 w = *(const u32x2*)(yr + 256 * c); float y8[8]; fp8x8_to_f32(w, y8);
                    acc[2 * c][0] += g * y8[0]; acc[2 * c][1] += g * y8[1]; acc[2 * c][2] += g * y8[2]; acc[2 * c][3] += g * y8[3];
                    acc[2 * c + 1][0] += g * y8[4]; acc[2 * c + 1][1] += g * y8[5]; acc[2 * c + 1][2] += g * y8[6]; acc[2 * c + 1][3] += g * y8[7]; }
            }
            const float* mp = mod + (size_t)((l - 1) * 9 + mr) * 6144 + 5 * 1024 + 8 * s; float s1 = 0.f;
#pragma unroll
            for (int c = 0; c < 4; ++c)
#pragma unroll
                for (int h = 0; h < 2; ++h) { const int j = 2 * c + h; const f32x4 g2 = *(const f32x4*)(mp + 256 * c + 4 * h); x[j] = ALPHA * x[j] + g2 * acc[j]; s1 += (x[j][0] + x[j][1]) + (x[j][2] + x[j][3]); }
            const float mean = sum32(s1) * (1.f / D); float s2 = 0.f;
#pragma unroll
            for (int j = 0; j < 8; ++j) { x[j] = x[j] - mean; s2 += (x[j][0] * x[j][0] + x[j][1] * x[j][1]) + (x[j][2] * x[j][2] + x[j][3] * x[j][3]); }
            const float rstd = 1.0f / sqrtf(sum32(s2) * (1.f / D) + 1e-6f);
            const float* gp = a.in[I_LN2G] + (l - 1) * 1024 + 8 * s; const float* bp = a.in[I_LN2B] + (l - 1) * 1024 + 8 * s;
#pragma unroll
            for (int c = 0; c < 4; ++c)
#pragma unroll
                for (int h = 0; h < 2; ++h) { const int j = 2 * c + h; x[j] = x[j] * rstd * *(const f32x4*)(gp + 256 * c + 4 * h) + *(const f32x4*)(bp + 256 * c + 4 * h); }
        }
        if (l == DEPTH) {
#pragma unroll
            for (int c = 0; c < 4; ++c) { *(f32x4*)(xo + 256 * c) = x[2 * c]; *(f32x4*)(xo + 256 * c + 4) = x[2 * c + 1]; } }
        else {
#pragma unroll
            for (int c = 0; c < 4; ++c) { u32x4 w; w.x = cvt_pk_f16(x[2 * c][0], x[2 * c][1]); w.y = cvt_pk_f16(x[2 * c][2], x[2 * c][3]); w.z = cvt_pk_f16(x[2 * c + 1][0], x[2 * c + 1][1]); w.w = cvt_pk_f16(x[2 * c + 1][2], x[2 * c + 1][3]); *(u32x4*)(xb + 256 * c) = w; } }
        if (l < DEPTH) { const float* mp = mod + (size_t)(l * 9 + mr) * 6144 + 8 * s; bf16_t* ho = H + (size_t)tok * D + 8 * s; unsigned char* ho8 = a.ws + WS_H8 + (size_t)tok * D + 8 * s;
#pragma unroll
            for (int c = 0; c < 4; ++c) { f32x4 h0, h1;
                { const f32x4 sh = *(const f32x4*)(mp + 256 * c), sc = *(const f32x4*)(mp + 1024 + 256 * c); h0 = x[2 * c] * (1.0f + sc) + sh; }
                { const f32x4 sh = *(const f32x4*)(mp + 256 * c + 4), sc = *(const f32x4*)(mp + 1024 + 256 * c + 4); h1 = x[2 * c + 1] * (1.0f + sc) + sh; }
                u32x4 w; w.x = cvt_pk_bf16(h0[0], h0[1]); w.y = cvt_pk_bf16(h0[2], h0[3]); w.z = cvt_pk_bf16(h1[0], h1[1]); w.w = cvt_pk_bf16(h1[2], h1[3]); *(u32x4*)(ho + 256 * c) = w;
                u32x2 w8; w8.x = cvt4_fp8_sat(h0[0], h0[1], h0[2], h0[3]); w8.y = cvt4_fp8_sat(h1[0], h1[1], h1[2], h1[3]); *(u32x2*)(ho8 + 256 * c) = w8; } }
    }
}

__device__ __forceinline__ void ph_thin(const Args& a, int l, int gw, int NGW, int lane) {
    bf16_t* BIG = (bf16_t*)(a.ws + WS_BIG); unsigned char* BR = a.ws + WS_BR; const float* rope = (const float*)(a.ws + WS_ROPE);
    const int sub = lane & 7, quarter = sub >> 1, c0 = 8 * lane;
    for (int q = gw; q < NTOK / 4; q += NGW) {
        const int tok0 = 4 * q; const bool lat = tok0 >= NCTX; const int t0 = lat ? ((tok0 - NCTX) & 2047) : (tok0 & 255), L = lat ? 2048 : 256;
        bf16_t* row0 = BIG + (size_t)tok0 * INW;
#pragma unroll
        for (int pass = 0; pass < 2; ++pass) {
            if (pass == 1 && lane >= 16) break;
            const float* gp = (pass == 0 ? a.in[I_QNG] : a.in[I_KNG]) + l * 64 + 8 * sub; float gw8[8];
#pragma unroll
            for (int i = 0; i < 8; ++i) gw8[i] = gp[i];
            u32x4 w[4];
#pragma unroll
            for (int k = 0; k < 4; ++k) w[k] = *(const u32x4*)(row0 + (size_t)k * INW + (pass == 0 ? C_GQ : C_GK) + 8 * lane);
#pragma unroll
            for (int k = 0; k < 4; ++k) { const int t = t0 + k; const int pos = quarter < 2 ? (t >> 6) : (t & 63);
                float x[8] = {bflo(w[k].x), bfhi(w[k].x), bflo(w[k].y), bfhi(w[k].y), bflo(w[k].z), bfhi(w[k].z), bflo(w[k].w), bfhi(w[k].w)};
                float ss = 0.f;
#pragma unroll
                for (int i = 0; i < 8; ++i) ss += x[i] * x[i];
                ss += __shfl_xor(ss, 1); ss += __shfl_xor(ss, 2); ss += __shfl_xor(ss, 4);
                const float rn = 1.0f / sqrtf(ss * (1.f / 64.f) + 1e-6f);
#pragma unroll
                for (int i = 0; i < 8; ++i) x[i] = x[i] * rn * gw8[i];
                if (lat) { const float* rp = rope + (pos * 16 + (sub & 1) * 8) * 2;
#pragma unroll
                    for (int i = 0; i < 8; ++i) { const float pr = __shfl_xor(x[i], 2); const float cs = rp[2 * i], sn = rp[2 * i + 1];
                        x[i] = (quarter & 1) ? (pr * sn + x[i] * cs) : (x[i] * cs - pr * sn); } }
                u32x4 o; o.x = cvt_pk_bf16(x[0], x[1]); o.y = cvt_pk_bf16(x[2], x[3]); o.z = cvt_pk_bf16(x[4], x[5]); o.w = cvt_pk_bf16(x[6], x[7]);
                *(u32x4*)(row0 + (size_t)k * INW + (pass == 0 ? C_GQ : C_GK) + 8 * lane) = o;
                if (pass == 1 && !lat) { float* so = a.out + O_SGK + ((size_t)((tok0 >> 8) * 4 + l) * 256 + t) * 128 + 8 * lane; *(f32x4*)so = (f32x4){x[0], x[1], x[2], x[3]}; *(f32x4*)(so + 4) = (f32x4){x[4], x[5], x[6], x[7]}; } }
        }
        { float u[6][8];
#pragma unroll
          for (int rr = 0; rr < 6; ++rr) { const int tt = t0 - 1 + rr;
              if (tt >= 0 && tt < L) { const bf16_t* p = row0 + (ptrdiff_t)(rr - 1) * INW; const u32x4 cw = *(const u32x4*)(p + C_CVC + c0), hw = *(const u32x4*)(p + C_CVH + c0);
                  u[rr][0] = bflo(cw.x) * bflo(hw.x); u[rr][1] = bfhi(cw.x) * bfhi(hw.x); u[rr][2] = bflo(cw.y) * bflo(hw.y); u[rr][3] = bfhi(cw.y) * bfhi(hw.y);
                  u[rr][4] = bflo(cw.z) * bflo(hw.z); u[rr][5] = bfhi(cw.z) * bfhi(hw.z); u[rr][6] = bflo(cw.w) * bflo(hw.w); u[rr][7] = bfhi(cw.w) * bfhi(hw.w); }
              else {
#pragma unroll
                  for (int i = 0; i < 8; ++i) u[rr][i] = 0.f; } }
          const float* cb = a.in[I_CONVB] + l * 512 + c0; const float* wk = a.in[I_CONVW] + (size_t)l * 3 * 512 + c0; float w0[8], w1[8], w2[8], bb[8];
#pragma unroll
          for (int i = 0; i < 8; ++i) { w0[i] = wk[i]; w1[i] = wk[512 + i]; w2[i] = wk[1024 + i]; bb[i] = cb[i]; }
#pragma unroll
          for (int k = 0; k < 4; ++k) { const u32x4 bw = *(const u32x4*)(row0 + (size_t)k * INW + C_CVB + c0); float y[8];
#pragma unroll
              for (int i = 0; i < 8; ++i) y[i] = bb[i] + w0[i] * u[k][i] + w1[i] * u[k + 1][i] + w2[i] * u[k + 2][i];
              u32x2 o; o.x = cvt4_fp8_sat(bflo(bw.x) * y[0], bfhi(bw.x) * y[1], bflo(bw.y) * y[2], bfhi(bw.y) * y[3]); o.y = cvt4_fp8_sat(bflo(bw.z) * y[4], bfhi(bw.z) * y[5], bflo(bw.w) * y[6], bfhi(bw.w) * y[7]);
              *(u32x2*)(BR + (size_t)(tok0 + k) * BRW + 1024 + c0) = o; } }
        { const int half = 1 << (lane >> 4); float sm[4][8], own[4][8];
#pragma unroll
          for (int k = 0; k < 4; ++k)
#pragma unroll
              for (int i = 0; i < 8; ++i) { sm[k][i] = 0.f; own[k][i] = 0.f; }
          for (int rr = t0 - half; rr < t0 + 3 + half; ++rr) { if (rr < 0 || rr >= L) continue;
              const u32x4 w = *(const u32x4*)(row0 + (ptrdiff_t)(rr - t0) * INW + C_PLU + c0);
              const float v[8] = {bflo(w.x), bfhi(w.x), bflo(w.y), bfhi(w.y), bflo(w.z), bfhi(w.z), bflo(w.w), bfhi(w.w)};
#pragma unroll
              for (int k = 0; k < 4; ++k) { const bool in = rr >= t0 + k - half && rr < t0 + k + half; const bool me = rr == t0 + k;
#pragma unroll
                  for (int i = 0; i < 8; ++i) { sm[k][i] += in ? v[i] : 0.f; own[k][i] = me ? v[i] : own[k][i]; } } }
#pragma unroll
          for (int k = 0; k < 4; ++k) { const int t = t0 + k; const float ic = 1.0f / (float)(min(t + half, L) - max(t - half, 0));
              u32x2 o; o.x = cvt4_fp8_sat(sm[k][0] * ic - own[k][0], sm[k][1] * ic - own[k][1], sm[k][2] * ic - own[k][2], sm[k][3] * ic - own[k][3]);
              o.y = cvt4_fp8_sat(sm[k][4] * ic - own[k][4], sm[k][5] * ic - own[k][5], sm[k][6] * ic - own[k][6], sm[k][7] * ic - own[k][7]);
              *(u32x2*)(BR + (size_t)(tok0 + k) * BRW + 1536 + c0) = o; } }
    }
}

__device__ __forceinline__ void ph_ln1(const Args& a, int l, LAS unsigned char* lds, int tid, int gw, int NGW, int lane) {
    LAS float* wrT = (LAS float*)lds;
    LAS float* gS = wrT + 16384; LAS float* bS = gS + 1024;
    { const float* src = a.in[I_WR] + (size_t)l * 1024 * 16; for (int i = tid; i < 16384; i += 512) wrT[(i & 15) * 1024 + (i >> 4)] = src[i];
      for (int i = tid; i < 1024; i += 512) { gS[i] = a.in[I_LN1G][l * 1024 + i]; bS[i] = a.in[I_LN1B][l * 1024 + i]; } }
    __syncthreads();
    const float* mod = (const float*)(a.ws + WS_MOD); const bf16_t* V = (const bf16_t*)(a.ws + WS_V); unsigned char* H8 = a.ws + WS_H8;
    float* aff = (float*)(a.ws + WS_AFF); float* afft = (float*)(a.ws + WS_AFFT);
    const int s = lane & 15, r = lane >> 4;
    const LAS float* gp = gS + 8 * s; const LAS float* bp = bS + 8 * s;
    for (int t0 = gw * 4; t0 < NTOK; t0 += NGW * 4) {
        const int tok = t0 + r; const float* mp = mod + (size_t)(l * 9 + modrow_of_tok(tok)) * 6144 + 8 * s; const bf16_t* vr = V + (size_t)tok * D + 8 * s;
        bf16_t* xo = (bf16_t*)(a.ws + WS_XB) + (size_t)tok * D + 8 * s; unsigned char* ho = H8 + (size_t)tok * D + 8 * s;
        f32x4 v[16]; float s1 = 0.f;
#pragma unroll
        for (int c = 0; c < 8; ++c) { const u32x4 w = *(const u32x4*)(vr + 128 * c); v[2 * c] = (f32x4){h16lo(w.x), h16hi(w.x), h16lo(w.y), h16hi(w.y)}; v[2 * c + 1] = (f32x4){h16lo(w.z), h16hi(w.z), h16lo(w.w), h16hi(w.w)}; }
#pragma unroll
        for (int j = 0; j < 16; ++j) s1 += (v[j][0] + v[j][1]) + (v[j][2] + v[j][3]);
        const float mean = sum16(s1) * (1.f / D); float s2 = 0.f;
#pragma unroll
        for (int j = 0; j < 16; ++j) { v[j] = v[j] - mean; s2 += (v[j][0] * v[j][0] + v[j][1] * v[j][1]) + (v[j][2] * v[j][2] + v[j][3] * v[j][3]); }
        const float rstd = 1.0f / sqrtf(sum16(s2) * (1.f / D) + 1e-6f);
        float p[16];
#pragma unroll
        for (int e = 0; e < 16; ++e) p[e] = 0.f;
        f32x4 msc[2], msh[2];
#pragma unroll
        for (int h = 0; h < 2; ++h) { msc[h] = *(const f32x4*)(mp + 4 * 1024 + 4 * h); msh[h] = *(const f32x4*)(mp + 3 * 1024 + 4 * h); }
#pragma unroll
        for (int c = 0; c < 8; ++c) { f32x4 hh[2], xx[2], nsc[2], nsh[2];
#pragma unroll
            for (int h = 0; h < 2; ++h) { const int o = 128 * (c < 7 ? c + 1 : c) + 4 * h; nsc[h] = *(const f32x4*)(mp + 4 * 1024 + o); nsh[h] = *(const f32x4*)(mp + 3 * 1024 + o); }
#pragma unroll
            for (int h = 0; h < 2; ++h) { const int o = 128 * c + 4 * h; const f32x4 x1 = v[2 * c + h] * rstd * *(const LAS f32x4*)(gp + o) + *(const LAS f32x4*)(bp + o); xx[h] = x1;
                hh[h] = x1 * (1.0f + msc[h]) + msh[h]; }
            { u32x4 w; w.x = cvt_pk_f16(xx[0][0], xx[0][1]); w.y = cvt_pk_f16(xx[0][2], xx[0][3]); w.z = cvt_pk_f16(xx[1][0], xx[1][1]); w.w = cvt_pk_f16(xx[1][2], xx[1][3]); *(u32x4*)(xo + 128 * c) = w; }
            { u32x2 w; w.x = cvt4_fp8_sat(hh[0][0], hh[0][1], hh[0][2], hh[0][3]); w.y = cvt4_fp8_sat(hh[1][0], hh[1][1], hh[1][2], hh[1][3]); *(u32x2*)(ho + 128 * c) = w; }
#pragma unroll
            for (int e = 0; e < 16; ++e) { const f32x4 w0 = *(const LAS f32x4*)(wrT + e * 1024 + 128 * c + 8 * s), w1 = *(const LAS f32x4*)(wrT + e * 1024 + 128 * c + 8 * s + 4);
                p[e] += (hh[0][0] * w0[0] + hh[0][1] * w0[1]) + (hh[0][2] * w0[2] + hh[0][3] * w0[3]) + (hh[1][0] * w1[0] + hh[1][1] * w1[1]) + (hh[1][2] * w1[2] + hh[1][3] * w1[3]); }
            asm volatile("" ::: "memory");
#pragma unroll
            for (int h = 0; h < 2; ++h) { msc[h] = nsc[h]; msh[h] = nsh[h]; } }
        float mx = -1e30f;
#pragma unroll
        for (int e = 0; e < 16; ++e) { p[e] = sum16(p[e]); mx = fmaxf(mx, p[e]); }
        float den = 0.f;
#pragma unroll
        for (int e = 0; e < 16; ++e) { p[e] = expf(p[e] - mx); den += p[e]; }
        float mine = 0.f;
#pragma unroll
        for (int e = 0; e < 16; ++e) mine = (s == e) ? p[e] / den : mine;
        aff[tok * 16 + s] = mine; afft[(size_t)s * NTOK + tok] = mine;
    }
}

__device__ __forceinline__ int block_excl_scan(int v, LAS int* sc, int tid, int& total) {
    const int lane = tid & 63, w = tid >> 6; int inc = v;
#pragma unroll
    for (int o = 1; o < 64; o <<= 1) { const int t = __shfl_up(inc, o); if (lane >= o) inc += t; }
    if (lane == 63) sc[w] = inc;
    __syncthreads();
    int off = 0, tot = 0;
#pragma unroll
    for (int i = 0; i < 8; ++i) { const int s = sc[i]; off += (i < w) ? s : 0; tot += s; }
    __syncthreads();
    total = tot; return off + inc - v;
}
__device__ __forceinline__ void ph_topk(const Args& a, LAS unsigned char* lds, int G, int bx, int tid) {
    LAS unsigned* keys = (LAS unsigned*)lds; LAS unsigned* hist = keys + 16384 + 512; LAS int* sc = (LAS int*)(hist + 4096); LAS unsigned* bc = (LAS unsigned*)(sc + 16);
    const float* afft = (const float*)(a.ws + WS_AFFT); int* slot = (int*)(a.ws + WS_SLOT); int* idx = (int*)(a.ws + WS_IDX);
    const int lane = tid & 63;
#define KIDX(j) ((j) + ((j) >> 5))
    for (int prob = bx; prob < 32; prob += G) {
        const bool lat = prob >= 16; const int e = prob & 15, n = lat ? NLAT : NCTX, cap = n >> 3, tbase = lat ? NCTX : 0, lbase = lat ? 16384 + e * 2048 : e * 1024;
        for (int i = tid; i < n; i += 512) keys[KIDX(i)] = __float_as_uint(afft[(size_t)e * NTOK + tbase + i]);
        unsigned prefix = 0u, mask = 0u; int krem = cap;
#pragma unroll 1
        for (int pass = 0; pass < 3; ++pass) { const int shift = pass == 0 ? 20 : pass == 1 ? 10 : 0, nbin = pass == 0 ? 4096 : 1024;
            for (int i = tid; i < nbin; i += 512) hist[i] = 0u;
            __syncthreads();
            for (int i = tid; i < n; i += 512) { const unsigned k = keys[KIDX(i)]; if ((k & mask) == prefix) atomicAdd((unsigned*)&hist[(k >> shift) & (unsigned)(nbin - 1)], 1u); }
            __syncthreads();
            if (tid < 64) { const int per = nbin >> 6; unsigned s = 0u;
                for (int b = 0; b < per; ++b) s += hist[per * lane + b];
                unsigned suf = s;
#pragma unroll
                for (int o = 1; o < 64; o <<= 1) { const unsigned t = __shfl_down(suf, o); if (lane + o < 64) suf += t; }
                unsigned cum = suf - s;
                if (cum < (unsigned)krem && cum + s >= (unsigned)krem) {
                    for (int b = per - 1; b >= 0; --b) { const unsigned c = hist[per * lane + b]; if (cum + c >= (unsigned)krem) { bc[0] = prefix | ((unsigned)(per * lane + b) << shift); bc[1] = (unsigned)krem - cum; break; } cum += c; } } }
            __syncthreads();
            prefix = bc[0]; krem = (int)bc[1]; mask |= (unsigned)(nbin - 1) << shift;
            __syncthreads();
        }
        const unsigned T = prefix; const int C = n >> 9, i0 = tid * C; int ceq = 0;
        for (int i = 0; i < C; ++i) ceq += (keys[KIDX(i0 + i)] == T) ? 1 : 0;
        int tot; int er = block_excl_scan(ceq, sc, tid, tot); int csel = 0; { int e2 = er;
            for (int i = 0; i < C; ++i) { const unsigned k = keys[KIDX(i0 + i)]; const bool sel = k > T || (k == T && e2 < krem); e2 += (k == T) ? 1 : 0; csel += sel ? 1 : 0; } }
        int so = block_excl_scan(csel, sc, tid, tot);
        for (int i = 0; i < C; ++i) { const unsigned k = keys[KIDX(i0 + i)]; const bool sel = k > T || (k == T && er < krem); er += (k == T) ? 1 : 0;
            keys[KIDX(i0 + i)] = sel ? (unsigned)so : 0xffffffffu; if (sel) { idx[lbase + so] = tbase + i0 + i; ++so; } }
        __syncthreads();
        for (int i = tid; i < n; i += 512) slot[(size_t)e * NTOK + tbase + i] = (int)keys[KIDX(i)];
        __syncthreads();
    }
#undef KIDX
}

__device__ __forceinline__ Args load_args() {
#if defined(__HIP_DEVICE_COMPILE__)
    const __attribute__((address_space(4))) unsigned char* p = (const __attribute__((address_space(4))) unsigned char*)__builtin_amdgcn_kernarg_segment_ptr(); asm volatile("" : "+s"(p));
    return *(const __attribute__((address_space(4))) Args*)p;
#else
    return Args{};
#endif
}
#define PH_VIEW() const Args a = load_args(); const int tid = opaque_v((int)threadIdx.x), lane = tid & 63, wave = __builtin_amdgcn_readfirstlane(tid >> 6); \
    const int G = opaque_s((int)gridDim.x), bx = opaque_s((int)blockIdx.x), gw = bx * 8 + wave, NGW = G * 8; LAS unsigned char* lds = (LAS unsigned char*)smem; (void)lane; (void)wave; (void)gw; (void)NGW; (void)lds; (void)tid
constexpr int N_PHASES = 2 + 10 * DEPTH;
#ifndef PH_MASK
#define PH_MASK 0xFFFF
#endif
#define PHON(j) (((PH_MASK) >> (j)) & 1)
#ifndef ATT_SHADOW
#define ATT_SHADOW 0
#endif
#ifndef REP_MASK
#define REP_MASK 0
#endif
#define NREP(j) (1 + (((REP_MASK) >> (j)) & 1))
__global__ void __launch_bounds__(512, 2) mk_fwd(Args a_) {
    extern __shared__ __attribute__((aligned(16))) unsigned char smem[];
    { volatile LAS unsigned* MISC = (volatile LAS unsigned*)((LAS unsigned char*)smem + MISC_OFF);
      if (threadIdx.x < 32) MISC[threadIdx.x] = 0u;
      __syncthreads();
      (void)xcd_barrier_post((unsigned*)(a_.ws + WS_CTL) + CW_BAR, MISC + 8); }
    const int lo = a_.ph_lo, hi = a_.ph_hi;
#define IN(k) (lo <= (k) && (k) < hi)
#define SEAM(k) do { if (IN(k) && IN((k) + 1)) { const Args sa = load_args(); XcdBarrier b; b.bar = (unsigned*)(sa.ws + WS_CTL) + CW_BAR; b.x = xb_xcc_id(); b.st = (volatile LAS unsigned*)((LAS unsigned char*)smem + MISC_OFF) + 8; xcd_barrier(b); } } while (0)
#define SEAMF() do { const Args sa = load_args(); XcdBarrier b; b.bar = (unsigned*)(sa.ws + WS_CTL) + CW_BAR; b.x = xb_xcc_id(); b.st = (volatile LAS unsigned*)((LAS unsigned char*)smem + MISC_OFF) + 8; xcd_barrier(b); } while (0)
    if (PHON(10) && IN(0)) for (int rep_ = 0; rep_ < NREP(10); ++rep_) { if (rep_) { SEAMF(); } { PH_VIEW(); ph_prologue(a, lds, G, bx, tid, wave, lane); } }
    SEAM(0);
    for (int l = 0; l < DEPTH; ++l) {
        const int pb = 1 + 10 * l;
        if (PHON(0) && IN(pb + 0)) { PH_VIEW(); ph_x(a, l, gw, NGW, lane); }
        SEAM(pb + 0);
        if (PHON(1) && IN(pb + 1)) for (int rep_ = 0; rep_ < NREP(1); ++rep_) { if (rep_) { SEAMF(); } { PH_VIEW(); { pg8::SchedLin S{G, bx, 96, C_F8 / 256, 1, (const char*)(a.ws + WS_H), (const char*)(a.ws + WS_WI) + (size_t)l * INW * 1024 * 2, 1024, 1024, 0, 0};
              pg8::EpiWin E{(bf16_t*)(a.ws + WS_BIG), a.out, l}; pg8::gemm_phase(lds, 1024, S, E); }
            { pg8::SchedLin S{G, bx, 96, NF8 / 256, 1, (const char*)(a.ws + WS_H8), (const char*)(a.ws + WS_WI8) + (size_t)l * NF8 * 1024, 512, 512, 0, 0};
              pg8::EpiWinGate E{(bf16_t*)(a.ws + WS_BIG)}; pg8::gemm_phase(lds, 512, S, E); } } }
        SEAM(pb + 1);
        if (PHON(2) && IN(pb + 2)) { PH_VIEW(); ph_thin(a, l, gw, NGW, lane); }
        SEAM(pb + 2);
        if (PHON(3) && IN(pb + 3)) for (int rep_ = 0; rep_ < NREP(3); ++rep_) { if (rep_) { SEAMF(); } { PH_VIEW(); ph_attention<0>(a, l, lds, G, bx); if (ATT_SHADOW) ph_attention<ATT_SHADOW>(a, l, lds, G, bx); } }
        SEAM(pb + 3);
        if (PHON(4) && IN(pb + 4)) for (int rep_ = 0; rep_ < NREP(4); ++rep_) { if (rep_) { SEAMF(); } { PH_VIEW(); pg8::SchedLin S{G, bx, 96, 4, 4, (const char*)(a.ws + WS_BR), (const char*)(a.ws + WS_WBR) + (size_t)l * 4 * 1024 * 512, BRW / 2, 256, 512, (size_t)1024 * 512};
            pg8::EpiBranch E{(const bf16_t*)(a.ws + WS_BIG), (bf16_t*)(a.ws + WS_MRG)}; pg8::gemm_phase(lds, 256, S, E); } }
        SEAM(pb + 4);
        if (PHON(5) && IN(pb + 5)) for (int rep_ = 0; rep_ < NREP(5); ++rep_) { if (rep_) { SEAMF(); } { PH_VIEW(); pg8::SchedLin S{G, bx, 96, 4, 1, (const char*)(a.ws + WS_MRG), (const char*)(a.ws + WS_WO) + (size_t)l * 1024 * 1024 * 2, 1024, 1024, 0, 0};
            pg8::EpiWout E{(const bf16_t*)(a.ws + WS_XB), (const float*)(a.ws + WS_MOD) + (size_t)l * 9 * 6144, (bf16_t*)(a.ws + WS_V)}; pg8::gemm_phase(lds, 1024, S, E); } }
        SEAM(pb + 5);
        if (PHON(6) && IN(pb + 6)) for (int rep_ = 0; rep_ < NREP(6); ++rep_) { if (rep_) { SEAMF(); } { PH_VIEW(); ph_ln1(a, l, lds, tid, gw, NGW, lane); } }
        SEAM(pb + 6);
        if (PHON(7) && IN(pb + 7)) for (int rep_ = 0; rep_ < NREP(7); ++rep_) { if (rep_) { SEAMF(); } { PH_VIEW(); ph_topk(a, lds, G, bx, tid); } }
        SEAM(pb + 7);
        if (PHON(8) && IN(pb + 8)) for (int rep_ = 0; rep_ < NREP(8); ++rep_) { if (rep_) { SEAMF(); } { PH_VIEW(); pg8::SchedGU S{G, bx, (const char*)(a.ws + WS_H8), (const char*)(a.ws + WS_WGU8) + (size_t)l * 16 * 2048 * 1024, (const int*)(a.ws + WS_IDX)};
            pg8::EpiGU E{a.ws + WS_HDN}; pg8::gemm_phase(lds, 512, S, E); } }
        SEAM(pb + 8);
        if (PHON(9) && IN(pb + 9)) for (int rep_ = 0; rep_ < NREP(9); ++rep_) { if (rep_) { SEAMF(); } { PH_VIEW(); pg8::SchedDown S{G, bx, (const char*)(a.ws + WS_HDN), (const char*)(a.ws + WS_WD8) + (size_t)l * 16 * 1024 * 1024};
            pg8::EpiDown E{a.ws + WS_YE}; pg8::gemm_phase(lds, 512, S, E); } }
        SEAM(pb + 9);
    }
    if (PHON(0) && IN(N_PHASES - 1)) { PH_VIEW(); ph_x(a, DEPTH, gw, NGW, lane); }
#undef IN
#undef SEAM
}

extern "C" void kernel_launch(void* const* d_in, const int* in_sizes, int n_in, void* d_out, int out_size, void* d_ws, size_t ws_size, hipStream_t stream) {
    static int grid = 0;
    if (grid == 0) {
        if (n_in != 28 || (size_t)out_size != O_END || ws_size < WS_END) { fprintf(stderr, "kernel_launch: unexpected problem (n_in %d, out %d, ws %zu); nothing launched\n", n_in, out_size, ws_size); grid = -1; return; }
        int dev = 0, cus = 0, per_cu = 0;
        if (hipGetDevice(&dev) != hipSuccess || hipDeviceGetAttribute(&cus, hipDeviceAttributeMultiprocessorCount, dev) != hipSuccess) { grid = -1; return; }
        if (hipFuncSetAttribute((const void*)mk_fwd, hipFuncAttributeMaxDynamicSharedMemorySize, LDS_BYTES) != hipSuccess) { fprintf(stderr, "kernel_launch: hipFuncSetAttribute failed\n"); grid = -1; return; }
        if (hipOccupancyMaxActiveBlocksPerMultiprocessor(&per_cu, (const void*)mk_fwd, 512, LDS_BYTES) != hipSuccess || per_cu < 1) { fprintf(stderr, "kernel_launch: occupancy query reports %d blocks per CU\n", per_cu); }
        (void)hipGetLastError();
        grid = cus;
    }
    if (grid < 0) return;
    (void)hipMemsetAsync((char*)d_ws + WS_CTL, 0, CTL_BYTES, stream);
    Args a{};
    for (int i = 0; i < 28; ++i) a.in[i] = (const float*)d_in[i];
    a.out = (float*)d_out; a.ws = (unsigned char*)d_ws;
#if MK_ONE_LAUNCH
    a.ph_lo = 0; a.ph_hi = N_PHASES;
    hipLaunchKernelGGL(mk_fwd, dim3(grid), dim3(512), LDS_BYTES, stream, a);
#else
    for (int p = 0; p < N_PHASES; ++p) { a.ph_lo = p; a.ph_hi = p + 1; hipLaunchKernelGGL(mk_fwd, dim3(grid), dim3(512), LDS_BYTES, stream, a); }
#endif
}
```

```cpp
#include <hip/hip_runtime.h>
#include <cstdio>
#include <cstdint>

#ifndef MK_ONE_LAUNCH
#define MK_ONE_LAUNCH 1
#endif

#define LAS __attribute__((address_space(3)))
typedef unsigned short bf16_t;
typedef short bf16x8 __attribute__((ext_vector_type(8)));
typedef float f32x4 __attribute__((ext_vector_type(4)));
typedef float f32x16 __attribute__((ext_vector_type(16)));
typedef unsigned u32x4 __attribute__((ext_vector_type(4)));
typedef unsigned u32x2 __attribute__((ext_vector_type(2)));

constexpr int D = 1024, NCTX = 8192, NLAT = 16384, NTOK = 24576, DEPTH = 4, INW = 8448;
constexpr int C_NAQ = 0, C_NAK = 512, C_NAV = 1024, C_GQ = 1536, C_GK = 2048, C_GV = 2176, C_CVB = 2304, C_CVC = 2816, C_CVH = 3328, C_PLU = 3840, C_GATE = 4352;
#ifndef C_F8_START
#define C_F8_START C_GATE
#endif
constexpr int C_F8 = C_F8_START, NF8 = INW - C_F8;
constexpr int BRW = 2048;
constexpr float ALPHA = 1.6817928305074290f;
constexpr float LOG2E = 1.4426950408889634f;
constexpr float C2 = 0.125f * 1.4426950408889634f;
constexpr size_t O_X = 0, O_SNAK = (size_t)NTOK * D, O_SNAV = O_SNAK + 16777216, O_SGK = O_SNAV + 16777216, O_SGV = O_SGK + 4194304, O_END = O_SGV + 4194304;
constexpr size_t MiB = 1u << 20;
constexpr size_t WS_CTL = 0, CTL_BYTES = 1 * MiB;
constexpr size_t WS_MOD = 1 * MiB;
constexpr size_t WS_ROPE = 2 * MiB - 16384;
constexpr size_t WS_AFF = 2 * MiB, WS_AFFT = WS_AFF + 1572864, WS_SLOT = WS_AFFT + 1572864, WS_IDX = WS_SLOT + 1572864;
constexpr size_t WS_STATS = 7 * MiB;
constexpr size_t WS_WI = 8 * MiB, WS_WBR = 74 * MiB, WS_WO = 90 * MiB;
constexpr size_t WS_WGU8 = 98 * MiB, WS_WD8 = 226 * MiB, WS_WI8 = 290 * MiB, WS_H8 = 320 * MiB;
constexpr size_t WS_CNAK = 482 * MiB, WS_CNAV = 498 * MiB, WS_CGK = 514 * MiB, WS_CGV = 518 * MiB;
constexpr size_t WS_H = 522 * MiB, WS_BIG = 570 * MiB, WS_V = WS_BIG, WS_HDN = WS_BIG + 96 * MiB, WS_YE = WS_BIG + 192 * MiB;
constexpr size_t WS_BR = 966 * MiB, WS_MRG = 1062 * MiB, WS_XB = 1110 * MiB, WS_END = 1158 * MiB;
static_assert(WS_IDX + 49152 * 4 <= WS_WI && WS_BIG + (size_t)NTOK * INW * 2 <= WS_BR, "ws map");
constexpr int CW_BAR = 4096;
constexpr size_t WS_ZERO = WS_CTL + 512 * 1024;
constexpr int RING_BYTES = 131072, MISC_OFF = RING_BYTES + 320, LDS_BYTES = 147456;

struct Args { const float* in[28]; float* out; unsigned char* ws; int ph_lo, ph_hi; };
enum { I_XP = 0, I_XS, I_CNAK, I_CNAV, I_CGK, I_CGV, I_C, I_CCTX, I_WADA, I_BADA, I_WIN, I_RPB, I_QNG, I_KNG, I_CONVW, I_CONVB, I_POOLW, I_POOLS, I_WBR, I_WOUT, I_LN1G, I_LN1B, I_LN2G, I_LN2B, I_WR, I_WG, I_WU, I_WDN };

#define LDS_WAIT() asm volatile("s_waitcnt lgkmcnt(0)" ::: "memory")
__device__ __forceinline__ unsigned cvt_pk_bf16(float lo, float hi) { unsigned r; asm("v_cvt_pk_bf16_f32 %0, %1, %2" : "=v"(r) : "v"(lo), "v"(hi)); return r; }
typedef _Float16 h16x2 __attribute__((ext_vector_type(2)));
__device__ __forceinline__ unsigned cvt_pk_f16(float lo, float hi) { const h16x2 v = {(_Float16)lo, (_Float16)hi}; return __builtin_bit_cast(unsigned, v); }
__device__ __forceinline__ float h16lo(unsigned w) { return (float)__builtin_bit_cast(h16x2, w)[0]; }
__device__ __forceinline__ float h16hi(unsigned w) { return (float)__builtin_bit_cast(h16x2, w)[1]; }
__device__ __forceinline__ unsigned cvt4_fp8(float a, float b, float c, float d) { int w = 0; w = __builtin_amdgcn_cvt_pk_fp8_f32(a, b, w, false); w = __builtin_amdgcn_cvt_pk_fp8_f32(c, d, w, true); return (unsigned)w; }
typedef float f32x2_t __attribute__((ext_vector_type(2)));
__device__ __forceinline__ void fp8x8_to_f32(u32x2 w, float (&o)[8]) { const f32x2_t a = __builtin_amdgcn_cvt_pk_f32_fp8((int)w.x, false), b = __builtin_amdgcn_cvt_pk_f32_fp8((int)w.x, true), c = __builtin_amdgcn_cvt_pk_f32_fp8((int)w.y, false), d = __builtin_amdgcn_cvt_pk_f32_fp8((int)w.y, true);
    o[0] = a[0]; o[1] = a[1]; o[2] = b[0]; o[3] = b[1]; o[4] = c[0]; o[5] = c[1]; o[6] = d[0]; o[7] = d[1]; }
__device__ __forceinline__ unsigned pack4_u8(float a, float b, float c, float d) { unsigned w = 0u; w = __builtin_amdgcn_cvt_pk_u8_f32(a, 0, w); w = __builtin_amdgcn_cvt_pk_u8_f32(b, 1, w); w = __builtin_amdgcn_cvt_pk_u8_f32(c, 2, w); w = __builtin_amdgcn_cvt_pk_u8_f32(d, 3, w); return w; }
__device__ __forceinline__ void u8x8_to_f32(u32x2 w, float (&o)[8]) { o[0] = (float)(w.x & 0xffu); o[1] = (float)((w.x >> 8) & 0xffu); o[2] = (float)((w.x >> 16) & 0xffu); o[3] = (float)(w.x >> 24);
    o[4] = (float)(w.y & 0xffu); o[5] = (float)((w.y >> 8) & 0xffu); o[6] = (float)((w.y >> 16) & 0xffu); o[7] = (float)(w.y >> 24); }
__device__ __forceinline__ float sat448(float v) { return __builtin_amdgcn_fmed3f(v, -448.0f, 448.0f); }
__device__ __forceinline__ unsigned cvt4_fp8_sat(float a, float b, float c, float d) { return cvt4_fp8(sat448(a), sat448(b), sat448(c), sat448(d)); }
constexpr float W8_SCALE = 64.0f;
__device__ __forceinline__ float bflo(unsigned w) { return __uint_as_float(w << 16); }
__device__ __forceinline__ float bfhi(unsigned w) { return __uint_as_float(w & 0xffff0000u); }
__device__ __forceinline__ int opaque_v(int v) { asm volatile("" : "+v"(v)); return v; }
__device__ __forceinline__ int opaque_s(int v) { v = __builtin_amdgcn_readfirstlane(v); asm volatile("" : "+s"(v)); return v; }
__device__ __forceinline__ float wave_sum(float v) {
#pragma unroll
    for (int o = 1; o < 64; o <<= 1) v += __shfl_xor(v, o);
    return v;
}
__device__ __forceinline__ float fast_exp2(float x) { return __builtin_amdgcn_exp2f(x); }
__device__ __forceinline__ float sigmoidf_(float z) { return __builtin_amdgcn_rcpf(1.0f + fast_exp2(-z * LOG2E)); }
__device__ __forceinline__ int modrow_of_tok(int tok) { return tok < NCTX ? 0 : 1 + ((tok - NCTX) >> 11); }

#define XB_TMO      128
#define XB_XCNT(j)  (256  + 64 * (j))
#define XB_XSUB(j)  (1280 + 64 * (j))
#define XB_XGEN(j)  (2304 + 64 * (j))
#define XB_TOP      3328
#define XB_TOPGEN   3392
#define XCD_BAR_WORDS 3456
#define XB_SPIN_CAP (1u << 18)
__device__ __forceinline__ unsigned xb_ld(unsigned* p)              { return __hip_atomic_load(p, __ATOMIC_RELAXED, __HIP_MEMORY_SCOPE_AGENT); }
__device__ __forceinline__ unsigned xb_add(unsigned* p, unsigned v) { return __hip_atomic_fetch_add(p, v, __ATOMIC_RELAXED, __HIP_MEMORY_SCOPE_AGENT); }
__device__ __forceinline__ unsigned xb_xcc_id() { return (unsigned)__builtin_amdgcn_s_getreg((3 << 11) | 20) & 0xFu; }
#define XB_SPIN(cond, bar) do { unsigned _sp = 0; while (cond) { __builtin_amdgcn_s_sleep(1); \
    if ((++_sp & 255u) == 0u) { if (xb_ld(&(bar)[XB_TMO])) break; if (_sp > XB_SPIN_CAP) { atomicAdd(&(bar)[XB_TMO], 1u); break; } } } } while (0)
struct XcdBarrier { unsigned* bar; unsigned x; volatile LAS unsigned* st; };
__device__ __forceinline__ XcdBarrier xcd_barrier_post(unsigned* bar, volatile LAS unsigned* st) {
    XcdBarrier b; b.bar = bar; b.x = xb_xcc_id(); b.st = st;
    if (threadIdx.x == 0) (void)xb_add(&bar[XB_XCNT(b.x)], 1u);
    return b;
}
__device__ __forceinline__ void xcd_barrier_complete(unsigned* bar, unsigned x, unsigned& nloc, unsigned& nx) {
    const unsigned G = gridDim.x * gridDim.y * gridDim.z;
    unsigned sum, cnt, mine, sp = 0u;
    for (;;) {
        sum = 0u; cnt = 0u; mine = 0u;
#pragma unroll
        for (unsigned j = 0; j < 16; ++j) { const unsigned c = xb_ld(&bar[XB_XCNT(j)]); sum += c; cnt += (c > 0u) ? 1u : 0u; mine = (j == x) ? c : mine; }
        if (sum == G) break;
        __builtin_amdgcn_s_sleep(1);
        if ((++sp & 255u) == 0u) { if (xb_ld(&bar[XB_TMO])) break; if (sp > XB_SPIN_CAP) { atomicAdd(&bar[XB_TMO], 1u); break; } }
    }
    nloc = mine > 0u ? mine : 1u; nx = cnt > 0u ? cnt : 1u;
}
__device__ __forceinline__ void xcd_barrier(const XcdBarrier& b) {
    asm volatile("s_waitcnt vmcnt(0)" ::: "memory");
    __syncthreads();
    if (threadIdx.x == 0) {
        unsigned* bar = b.bar;
        __builtin_amdgcn_s_waitcnt(0);
        unsigned nloc = b.st[0], nx = b.st[1];
        if (nloc == 0u) { xcd_barrier_complete(bar, b.x, nloc, nx); b.st[0] = nloc; b.st[1] = nx; }
        const unsigned old = xb_add(&bar[XB_XSUB(b.x)], 1u);
        const unsigned gen = old / nloc;
        if (old + 1u == (gen + 1u) * nloc) {
            __builtin_amdgcn_fence(__ATOMIC_RELEASE, "agent");
            asm volatile("s_waitcnt vmcnt(0)" ::: "memory");
            const unsigned og = xb_add(&bar[XB_TOP], 1u);
            const unsigned tg = og / nx;
            if (og + 1u == (tg + 1u) * nx) xb_add(&bar[XB_TOPGEN], 1u);
            else XB_SPIN(xb_ld(&bar[XB_TOPGEN]) == tg, bar);
            __builtin_amdgcn_fence(__ATOMIC_ACQUIRE, "agent");
            xb_add(&bar[XB_XGEN(b.x)], 1u);
            asm volatile("s_waitcnt vmcnt(0)" ::: "memory");
        } else {
            XB_SPIN(xb_ld(&bar[XB_XGEN(b.x)]) == gen, bar);
            __builtin_amdgcn_fence(__ATOMIC_ACQUIRE, "agent");
            asm volatile("s_waitcnt vmcnt(0)" ::: "memory");
        }
    }
    __syncthreads();
}

#ifndef PG8_WGM
#define PG8_WGM 8
#endif
#ifndef PG8_ALIGN_EPI
#define PG8_ALIGN_EPI 1
#endif
namespace pg8 {
constexpr int BM = 256, BK = 64, HALF = 128, HTB = HALF * BK * 2, STAGE_BYTES = 8 * HTB;
__device__ __forceinline__ int lds_byte(int r, int c) { const int st = (r >> 4) * 2 + (c >> 5), rr = r & 15, cc = c & 31, ob = rr * 64 + cc * 2; return st * 1024 + (ob ^ (((ob >> 9) & 1) << 5)); }
__device__ __forceinline__ void stage_rc(int b, int& R, int& C) { const int st = b / 1024, sb = b % 1024, swz = sb ^ (((sb >> 9) & 1) << 5); R = (st >> 1) * 16 + swz / 64; C = (st & 1) * 32 + (swz % 64) / 2; }
__device__ __forceinline__ int perm32(int rho) { const int n = rho >> 4, i = rho & 15; return 8 * (i >> 2) + 4 * n + (i & 3); }
__device__ __forceinline__ int xcd_remap(int L, int nwg) { const int q = nwg >> 3, r = nwg & 7, xcd = L & 7, off = L >> 3; return (xcd < r ? xcd * (q + 1) : r * (q + 1) + (xcd - r) * q) + off; }

struct GUnit { const char* A; const char* B; int pm, pn, aux, rowbase; };

template <class Epi, class Sched>
__device__ __forceinline__ void gemm_phase(LAS unsigned char* lds, const int K, const Sched& S, const Epi& E) {
    const int tid = opaque_v((int)threadIdx.x), wid = __builtin_amdgcn_readfirstlane(tid >> 6), lane = tid & 63, wr = wid >> 2, wc = wid & 3, fr = lane & 15, fq = lane >> 4;
    const int nt = K / BK;
    int sR[2], sC[2]; unsigned voffB[2];
#pragma unroll
    for (int i = 0; i < 2; ++i) { int R, C; stage_rc(tid * 16 + i * 8192, R, C); const int Rb = Epi::PERM ? ((R & ~31) + perm32(R & 31)) : R; sR[i] = R; sC[i] = C; voffB[i] = (unsigned)(Rb * K + C) * 2u; }
    const size_t kstep = (size_t)(BK * 2);
    const size_t hstep = (size_t)HALF * K * 2;
    const unsigned ldsw = (unsigned)wid * 1024u;
    const int aoff = lds_byte(wr * 64 + fr, fq * 8), boff = lds_byte(wc * 32 + fr, fq * 8);
#define PG8_SA(b, h) (((b) * 2 + (h)) * HTB)
#define PG8_SB(b, h) ((4 + (b) * 2 + (h)) * HTB)
#define PG8_STAGE(bufoff, gbase, v0, v1) do { \
        __builtin_amdgcn_global_load_lds((const unsigned*)((const char*)(gbase) + (v0)), (LAS unsigned*)(lds + (bufoff) + ldsw), 16, 0, 0); \
        __builtin_amdgcn_global_load_lds((const unsigned*)((const char*)(gbase) + (v1)), (LAS unsigned*)(lds + (bufoff) + ldsw + 8192), 16, 0, 0); } while (0)
#define PG8_STAGE_B(bufoff, gbase) PG8_STAGE(bufoff, gbase, voffB[0], voffB[1])
#define PG8_LDA(dst, b, h) do { _Pragma("unroll") for (int m = 0; m < 4; ++m) _Pragma("unroll") for (int k = 0; k < 2; ++k) dst[m][k] = *(const LAS bf16x8*)(lds + PG8_SA(b, h) + aoff + m * 2048 + k * 1024); } while (0)
#define PG8_LDB(dst, b, h) do { _Pragma("unroll") for (int n = 0; n < 2; ++n) _Pragma("unroll") for (int k = 0; k < 2; ++k) dst[n][k] = *(const LAS bf16x8*)(lds + PG8_SB(b, h) + boff + n * 2048 + k * 1024); } while (0)
#define PG8_MMA(ai, bj, At, Bt) do { __builtin_amdgcn_s_setprio(1); _Pragma("unroll") for (int m = 0; m < 4; ++m) _Pragma("unroll") for (int n = 0; n < 2; ++n) { \
        if constexpr (Epi::FP8) { typedef int v4i_ __attribute__((ext_vector_type(4))); typedef int v8i_ __attribute__((ext_vector_type(8))); \
            const v8i_ wf = __builtin_shufflevector(__builtin_bit_cast(v4i_, Bt[n][0]), __builtin_bit_cast(v4i_, Bt[n][1]), 0, 1, 2, 3, 4, 5, 6, 7); \
            const v8i_ af = __builtin_shufflevector(__builtin_bit_cast(v4i_, At[m][0]), __builtin_bit_cast(v4i_, At[m][1]), 0, 1, 2, 3, 4, 5, 6, 7); \
            asm volatile("v_mfma_scale_f32_16x16x128_f8f6f4 %0, %1, %2, %0, %3, %4 op_sel_hi:[0,0,0]" : "+v"(acc[ai][bj][m][n]) : "v"(wf), "v"(af), "v"(scl_w), "v"(scl_a)); \
        } else { _Pragma("unroll") for (int k = 0; k < 2; ++k) acc[ai][bj][m][n] = __builtin_amdgcn_mfma_f32_16x16x32_bf16(Bt[n][k], At[m][k], acc[ai][bj][m][n], 0, 0, 0); } } \
        __builtin_amdgcn_s_setprio(0); } while (0)
#define PG8_WAIT_V(n) asm volatile("s_waitcnt vmcnt(" #n ")" ::: "memory")
#define PG8_WAIT_L(n) asm volatile("s_waitcnt lgkmcnt(" #n ")" ::: "memory")
#define PG8_BAR __builtin_amdgcn_s_barrier()
#define PG8_SCHED __builtin_amdgcn_sched_barrier(0)
    GUnit cur, nxt; int ui = 0;
    if (!S.next(0, cur)) return;
    const int scl_w = 0x79797979, scl_a = 0x7f7f7f7f;
    (void)scl_w; (void)scl_a;
    f32x4 acc[2][2][4][2];
#pragma unroll
    for (int a = 0; a < 2; ++a)
#pragma unroll
        for (int b = 0; b < 2; ++b)
#pragma unroll
            for (int m = 0; m < 4; ++m)
#pragma unroll
                for (int n = 0; n < 2; ++n) acc[a][b][m][n] = (f32x4){0.f, 0.f, 0.f, 0.f};
    bf16x8 At[4][2], B0[2][2], B1[2][2];
    unsigned vA00, vA01, vA10, vA11, vN00 = 0, vN01 = 0, vN10 = 0, vN11 = 0;
    vA00 = S.a_off(cur, sR[0], sC[0]); vA01 = S.a_off(cur, sR[1], sC[1]);
    if constexpr (Sched::GATHER) { vA10 = S.a_off(cur, HALF + sR[0], sC[0]); vA11 = S.a_off(cur, HALF + sR[1], sC[1]); } else { vA10 = vA00; vA11 = vA01; }
    const size_t hA = Sched::GATHER ? (size_t)0 : S.a_hstep();
    const char* cA = cur.A; const char* cB = cur.B;
    PG8_STAGE_B(PG8_SB(0, 0), cB); PG8_STAGE_B(PG8_SB(0, 1), cB + hstep); PG8_STAGE(PG8_SA(0, 0), cA, vA00, vA01); PG8_STAGE(PG8_SA(0, 1), cA + hA, vA10, vA11);
    if (wr == 1) PG8_BAR;
    PG8_WAIT_V(2); PG8_BAR;
    PG8_STAGE_B(PG8_SB(1, 0), cB + kstep); PG8_STAGE(PG8_SA(1, 0), cA + kstep, vA00, vA01); PG8_STAGE_B(PG8_SB(1, 1), cB + hstep + kstep);
    PG8_WAIT_V(6); PG8_BAR;
    for (;;) {
        const bool has_next = S.next(ui + 1, nxt);
        const char* nA = has_next ? nxt.A : cA; const char* nB = has_next ? nxt.B : cB;
        if constexpr (Sched::GATHER) { vN00 = vA00; vN01 = vA01; vN10 = vA10; vN11 = vA11;
            if (has_next) { vN00 = S.a_off(nxt, sR[0], sC[0]); vN01 = S.a_off(nxt, sR[1], sC[1]); vN10 = S.a_off(nxt, HALF + sR[0], sC[0]); vN11 = S.a_off(nxt, HALF + sR[1], sC[1]); } }
        for (int t = 0; t < nt; t += 2) {
            const bool last = (t == nt - 2);
            const char* a1 = cA + (size_t)(t + 1) * kstep;
            const char* a2 = last ? nA : cA + (size_t)(t + 2) * kstep; const char* b2 = last ? nB : cB + (size_t)(t + 2) * kstep;
            const char* a3 = a2 + kstep; const char* b3 = b2 + kstep;
            PG8_LDB(B0, 0, 0); PG8_LDB(B1, 0, 1); PG8_SCHED; PG8_LDA(At, 0, 0); PG8_STAGE(PG8_SA(1, 1), a1 + hA, vA10, vA11);
            if constexpr (Sched::GATHER) { if (last) { vA00 = vN00; vA01 = vN01; vA10 = vN10; vA11 = vN11; } }
            PG8_WAIT_V(8); PG8_WAIT_L(0); PG8_BAR; PG8_MMA(0, 0, At, B0); PG8_MMA(0, 1, At, B1); PG8_BAR; PG8_SCHED;
            PG8_LDA(At, 0, 1); PG8_STAGE_B(PG8_SB(0, 0), b2); PG8_STAGE_B(PG8_SB(0, 1), b2 + hstep); PG8_STAGE(PG8_SA(0, 0), a2, vA00, vA01);
            PG8_WAIT_V(8); PG8_WAIT_L(0); PG8_BAR; PG8_MMA(1, 0, At, B0); PG8_MMA(1, 1, At, B1); PG8_BAR; PG8_SCHED;
            PG8_LDB(B0, 1, 0); PG8_LDB(B1, 1, 1); PG8_SCHED; PG8_LDA(At, 1, 0); PG8_STAGE(PG8_SA(0, 1), a2 + hA, vA10, vA11);
            PG8_WAIT_V(8); PG8_WAIT_L(0); PG8_BAR; PG8_MMA(0, 0, At, B0); PG8_MMA(0, 1, At, B1); PG8_BAR; PG8_SCHED;
            PG8_LDA(At, 1, 1); PG8_STAGE_B(PG8_SB(1, 0), b3); PG8_STAGE_B(PG8_SB(1, 1), b3 + hstep); PG8_STAGE(PG8_SA(1, 0), a3, vA00, vA01);
            PG8_WAIT_V(8); PG8_WAIT_L(0); PG8_BAR; PG8_MMA(1, 0, At, B0); PG8_MMA(1, 1, At, B1); PG8_BAR; PG8_SCHED;
        }
        if (PG8_ALIGN_EPI) { if (wr == 0) PG8_BAR; }
        if constexpr (Epi::FP8) asm volatile("s_nop 15\n\ts_nop 15" ::: "memory");
        const bool reset = E(acc, cur, wr, wc, fr, fq);
        if (!has_next) break;
        if (reset) {
#pragma unroll
            for (int a = 0; a < 2; ++a)
#pragma unroll
                for (int b = 0; b < 2; ++b)
#pragma unroll
                    for (int m = 0; m < 4; ++m)
#pragma unroll
                        for (int n = 0; n < 2; ++n) acc[a][b][m][n] = (f32x4){0.f, 0.f, 0.f, 0.f};
        }
        cur = nxt; cA = nA; cB = nB; ++ui;
        if (PG8_ALIGN_EPI) { if (wr == 1) PG8_BAR; }
    }
    PG8_WAIT_V(0);
    if (!PG8_ALIGN_EPI) { if (wr == 0) PG8_BAR; }
    PG8_BAR;
#undef PG8_SA
#undef PG8_SB
#undef PG8_STAGE
#undef PG8_STAGE_B
#undef PG8_LDA
#undef PG8_LDB
#undef PG8_MMA
#undef PG8_WAIT_V
#undef PG8_WAIT_L
#undef PG8_BAR
#undef PG8_SCHED
}

struct SchedLin {
    static constexpr bool GATHER = false;
    int G, c, nM, nN, nsub; const char* A; const char* B; int lda, K; size_t asub, bsub;
    __device__ __forceinline__ size_t a_hstep() const { return (size_t)HALF * lda * 2; }
    __device__ __forceinline__ bool next(int i, GUnit& u) const {
        const int j = i / nsub, nb = i - j * nsub; const int L = j * G + c; const int nwg = nM * nN; if (L >= nwg) return false;
        const int wg = xcd_remap(L, nwg), nig = PG8_WGM * nN, gid = wg / nig, fm = gid * PG8_WGM, rem = wg - gid * nig, gsz = (nM - fm) < PG8_WGM ? (nM - fm) : PG8_WGM;
        u.pm = fm + rem % gsz; u.pn = rem / gsz; u.aux = nb; u.rowbase = u.pm * BM;
        u.A = A + (size_t)u.pm * BM * lda * 2 + nb * asub; u.B = B + (size_t)u.pn * BM * K * 2 + nb * bsub; return true;
    }
    __device__ __forceinline__ unsigned a_off(const GUnit&, int row, int col) const { return (unsigned)(row * lda + col) * 2u; }
};
struct SchedGU {
    static constexpr bool GATHER = true;
    int G, c; const char* H; const char* W; const int* idx;
    __device__ __forceinline__ size_t a_hstep() const { return 0; }
    __device__ __forceinline__ bool next(int i, GUnit& u) const {
        const int L = i * G + c; if (L >= 1536) return false;
        const int wg = xcd_remap(L, 1536); int e, pm, pn, lb;
        if (wg < 1024) { e = wg >> 6; const int r = wg & 63; pm = r & 7; pn = r >> 3; lb = 16384 + e * 2048; }
        else { const int w2 = wg - 1024; e = w2 >> 5; const int r = w2 & 31; pm = r & 3; pn = r >> 2; lb = e * 1024; }
        u.pm = pm; u.pn = pn; u.aux = e; u.rowbase = lb + pm * BM; u.A = H; u.B = W + ((size_t)e * 2048 + (size_t)pn * BM) * 1024; return true;
    }
    __device__ __forceinline__ unsigned a_off(const GUnit& u, int row, int col) const { return (unsigned)(idx[u.rowbase + row] * 512 + col) * 2u; }
};
struct SchedDown {
    static constexpr bool GATHER = false;
    int G, c; const char* A; const char* W;
    __device__ __forceinline__ size_t a_hstep() const { return (size_t)HALF * 1024; }
    __device__ __forceinline__ bool next(int i, GUnit& u) const {
        const int L = i * G + c; if (L >= 768) return false;
        const int wg = xcd_remap(L, 768); const int pm = wg >> 2, pn = wg & 3; const int e = pm < 64 ? (pm >> 2) : ((pm - 64) >> 3);
        u.pm = pm; u.pn = pn; u.aux = e; u.rowbase = pm * BM; u.A = A + (size_t)pm * BM * 1024; u.B = W + ((size_t)e * 1024 + (size_t)pn * BM) * 1024; return true;
    }
    __device__ __forceinline__ unsigned a_off(const GUnit&, int row, int col) const { return (unsigned)(row * 512 + col) * 2u; }
};

struct EpiWin {
    static constexpr bool PERM = true, FP8 = false; bf16_t* BIG; float* out; int layer;
    __device__ __forceinline__ bool operator()(f32x4 (&acc)[2][2][4][2], const GUnit& u, int wr, int wc, int fr, int fq) const {
        const int pm = u.pm, pn = u.pn; const float qs = (pn + 1) * BM <= C_NAK ? C2 : 1.0f;
#pragma unroll
        for (int bj = 0; bj < 2; ++bj) {
            const int col = pn * BM + bj * HALF + wc * 32 + 8 * fq;
            float* sp = nullptr; int spitch = 0, scol = 0;
            if (pm < 32) {
                if (col >= C_NAK && col < C_NAV) { sp = out + O_SNAK; spitch = 512; scol = col - C_NAK; }
                else if (col >= C_NAV && col < C_GQ) { sp = out + O_SNAV; spitch = 512; scol = col - C_NAV; }
                else if (col >= C_GV && col < C_CVB) { sp = out + O_SGV; spitch = 128; scol = col - C_GV; }
            }
#pragma unroll
            for (int ai = 0; ai < 2; ++ai)
#pragma unroll
                for (int m = 0; m < 4; ++m) {
                    const int t = ai * HALF + wr * 64 + m * 16 + fr; const size_t row = (size_t)pm * BM + t;
                    const f32x4 v0 = acc[ai][bj][m][0], v1 = acc[ai][bj][m][1]; const f32x4 s0 = v0 * qs, s1 = v1 * qs;
                    u32x4 w; w.x = cvt_pk_bf16(s0[0], s0[1]); w.y = cvt_pk_bf16(s0[2], s0[3]); w.z = cvt_pk_bf16(s1[0], s1[1]); w.w = cvt_pk_bf16(s1[2], s1[3]);
                    *(u32x4*)(BIG + row * INW + col) = w;
                    if (sp) { float* o = sp + ((size_t)(pm * 4 + layer) * 256 + t) * spitch + scol; *(f32x4*)o = v0; *(f32x4*)(o + 4) = v1; }
                }
        }
        return true;
    }
};
struct EpiWinGate {
    static constexpr bool PERM = true, FP8 = true; bf16_t* BIG;
    __device__ __forceinline__ bool operator()(f32x4 (&acc)[2][2][4][2], const GUnit& u, int wr, int wc, int fr, int fq) const {
#pragma unroll
        for (int bj = 0; bj < 2; ++bj) {
            const int col = C_F8 + u.pn * BM + bj * HALF + wc * 32 + 8 * fq; const bool gate = col >= C_GATE;
#pragma unroll
            for (int ai = 0; ai < 2; ++ai)
#pragma unroll
                for (int m = 0; m < 4; ++m) {
                    const size_t row = (size_t)u.pm * BM + ai * HALF + wr * 64 + m * 16 + fr;
                    f32x4 v0 = acc[ai][bj][m][0], v1 = acc[ai][bj][m][1];
                    if (gate) {
#pragma unroll
                        for (int j = 0; j < 4; ++j) { v0[j] = fmaxf(sigmoidf_(v0[j]) * 255.0f, 1.0f); v1[j] = fmaxf(sigmoidf_(v1[j]) * 255.0f, 1.0f); }
                        u32x2 w; w.x = pack4_u8(v0[0], v0[1], v0[2], v0[3]); w.y = pack4_u8(v1[0], v1[1], v1[2], v1[3]);
                        *(u32x2*)((unsigned char*)(BIG + row * INW + C_GATE) + (col - C_GATE)) = w;
                    } else { u32x4 w; w.x = cvt_pk_bf16(v0[0], v0[1]); w.y = cvt_pk_bf16(v0[2], v0[3]); w.z = cvt_pk_bf16(v1[0], v1[1]); w.w = cvt_pk_bf16(v1[2], v1[3]);
                        *(u32x4*)(BIG + row * INW + col) = w; }
                }
        }
        return true;
    }
};
struct EpiBranch {
    static constexpr bool PERM = true, FP8 = true; const bf16_t* BIG; bf16_t* MRG;
    __device__ __forceinline__ bool operator()(f32x4 (&acc)[2][2][4][2], const GUnit& u, int wr, int wc, int fr, int fq) const {
        const int nb = u.aux; const bool last = nb == 3; const int dofs = last ? 0 : 1024;
#pragma unroll
        for (int ai = 0; ai < 2; ++ai) {
            const size_t row0 = (size_t)u.pm * BM + ai * HALF + wr * 64 + fr; const int col0 = u.pn * BM + wc * 32 + 8 * fq;
            const unsigned char* gp = (const unsigned char*)(BIG + row0 * INW + C_GATE) + nb * 1024 + col0;
#pragma unroll
            for (int bj = 0; bj < 2; ++bj) {
                u32x2 g0[4], g1[4];
#pragma unroll
                for (int m = 0; m < 4; ++m) { g0[m] = *(const u32x2*)(gp + (size_t)m * 16 * INW * 2 + bj * HALF); g1[m] = *(const u32x2*)(gp + (size_t)m * 16 * INW * 2 + bj * HALF + dofs); }
#pragma unroll
                for (int m = 0; m < 4; ++m) {
                    float s[8], d[8]; u8x8_to_f32(g0[m], s); u8x8_to_f32(g1[m], d);
#pragma unroll
                    for (int j = 0; j < 8; ++j) s[j] = last ? s[j] * (1.0f / 255.0f) : s[j] * __builtin_amdgcn_rcpf(d[j]);
                    f32x4 v0 = acc[ai][bj][m][0], v1 = acc[ai][bj][m][1];
#pragma unroll
                    for (int j = 0; j < 4; ++j) { v0[j] *= s[j]; v1[j] *= s[4 + j]; }
                    acc[ai][bj][m][0] = v0; acc[ai][bj][m][1] = v1;
                    if (last) { u32x4 w; w.x = cvt_pk_bf16(v0[0], v0[1]); w.y = cvt_pk_bf16(v0[2], v0[3]); w.z = cvt_pk_bf16(v1[0], v1[1]); w.w = cvt_pk_bf16(v1[2], v1[3]);
                        *(u32x4*)(MRG + (row0 + m * 16) * D + col0 + bj * HALF) = w; }
                }
                asm volatile("" ::: "memory");
            }
        }
        return last;
    }
};
struct EpiWout {
    static constexpr bool PERM = true, FP8 = false; const bf16_t* x; const float* mod; bf16_t* V;
    __device__ __forceinline__ bool operator()(f32x4 (&acc)[2][2][4][2], const GUnit& u, int wr, int wc, int fr, int fq) const {
        const int mr = u.pm < 32 ? 0 : 1 + ((u.pm - 32) >> 3); const float* g1 = mod + mr * 6144 + 2048;
#pragma unroll
        for (int bj = 0; bj < 2; ++bj) {
            const int col = u.pn * BM + bj * HALF + wc * 32 + 8 * fq; const f32x4 gv0 = *(const f32x4*)(g1 + col), gv1 = *(const f32x4*)(g1 + col + 4);
            const size_t off0 = ((size_t)u.pm * BM + wr * 64 + fr) * D + col;
#pragma unroll
            for (int ai = 0; ai < 2; ++ai) {
                u32x4 xv[4];
#pragma unroll
                for (int m = 0; m < 4; ++m) xv[m] = *(const u32x4*)(x + off0 + (size_t)(ai * HALF + m * 16) * D);
#pragma unroll
                for (int m = 0; m < 4; ++m) { const u32x4 a = xv[m]; const f32x4 x0 = {h16lo(a.x), h16hi(a.x), h16lo(a.y), h16hi(a.y)}, x1 = {h16lo(a.z), h16hi(a.z), h16lo(a.w), h16hi(a.w)};
                    const f32x4 v0 = ALPHA * x0 + gv0 * acc[ai][bj][m][0], v1 = ALPHA * x1 + gv1 * acc[ai][bj][m][1];
                    u32x4 w; w.x = cvt_pk_f16(v0[0], v0[1]); w.y = cvt_pk_f16(v0[2], v0[3]); w.z = cvt_pk_f16(v1[0], v1[1]); w.w = cvt_pk_f16(v1[2], v1[3]);
                    *(u32x4*)(V + off0 + (size_t)(ai * HALF + m * 16) * D) = w; }
                asm volatile("" ::: "memory");
            }
        }
        return true;
    }
};
struct EpiGU {
    static constexpr bool PERM = true, FP8 = true; unsigned char* HDN8;
    __device__ __forceinline__ bool operator()(f32x4 (&acc)[2][2][4][2], const GUnit& u, int wr, int wc, int fr, int fq) const {
#pragma unroll
        for (int ai = 0; ai < 2; ++ai)
#pragma unroll
            for (int m = 0; m < 4; ++m) { const size_t row = (size_t)u.rowbase + ai * HALF + wr * 64 + m * 16 + fr; float h[8];
#pragma unroll
                for (int n = 0; n < 2; ++n)
#pragma unroll
                    for (int j = 0; j < 4; ++j) { const float g = acc[ai][0][m][n][j], up = acc[ai][1][m][n][j]; h[4 * n + j] = g * sigmoidf_(g) * up; }
                u32x2 w; w.x = cvt4_fp8_sat(h[0], h[1], h[2], h[3]); w.y = cvt4_fp8_sat(h[4], h[5], h[6], h[7]);
                *(u32x2*)(HDN8 + row * 1024 + u.pn * HALF + wc * 32 + 8 * fq) = w; }
        return true;
    }
};
struct EpiDown {
    static constexpr bool PERM = true, FP8 = true; unsigned char* YE8;
    __device__ __forceinline__ bool operator()(f32x4 (&acc)[2][2][4][2], const GUnit& u, int wr, int wc, int fr, int fq) const {
#pragma unroll
        for (int ai = 0; ai < 2; ++ai)
#pragma unroll
            for (int m = 0; m < 4; ++m) { const size_t row = (size_t)u.rowbase + ai * HALF + wr * 64 + m * 16 + fr;
#pragma unroll
                for (int bj = 0; bj < 2; ++bj) { const f32x4 v0 = acc[ai][bj][m][0] * 16.0f, v1 = acc[ai][bj][m][1] * 16.0f;
                    u32x2 w; w.x = cvt4_fp8_sat(v0[0], v0[1], v0[2], v0[3]); w.y = cvt4_fp8_sat(v1[0], v1[1], v1[2], v1[3]);
                    *(u32x2*)(YE8 + row * 1024 + u.pn * BM + bj * HALF + wc * 32 + 8 * fq) = w; } }
        return true;
    }
};
}

struct AUnit { int opitch; const bf16_t* q; unsigned char* o; const bf16_t* k0; const bf16_t* v0; const bf16_t* k1; const bf16_t* v1; int pitch0, pitch1, nt0, nt1, na, qrow0, krow0; const float* rpb; };
constexpr int KP = 72;
constexpr int VPB = 192;
constexpr int ATT_KBUF = 64 * KP * 2, ATT_VBUF = 64 * VPB, ATT_K = 0, ATT_V = 4 * ATT_KBUF, ATT_RPB = ATT_V + 4 * ATT_VBUF;
static_assert(ATT_RPB + 465 * 4 <= RING_BYTES, "attention LDS");
typedef short v4i16_t __attribute__((ext_vector_type(4)));
__device__ __forceinline__ u32x2 vtr(const LAS unsigned char* p) { return __builtin_bit_cast(u32x2, __builtin_amdgcn_ds_read_tr16_b64_v4i16((LAS v4i16_t*)p)); }

struct APre { bf16x8 q[4]; u32x4 kA, vA, kB, vB; float rpb; };
__device__ __forceinline__ void att_tile_ptrs(const AUnit& u, int t, int skey, int sch, const bf16_t*& kp, const bf16_t*& vp) {
    if (t < u.nt0) { const size_t o = (size_t)(t * 64 + skey) * u.pitch0 + sch * 8; kp = u.k0 + o; vp = u.v0 + o; }
    else { const size_t o = (size_t)((t - u.nt0) * 64 + skey) * u.pitch1 + sch * 8; kp = u.k1 + o; vp = u.v1 + o; }
}
__device__ __forceinline__ void att_pre_q(const AUnit& u, int tid, APre& p) {
    const int lane = tid & 63, wid = tid >> 6; const bf16_t* qp = u.q + (size_t)(wid * 32 + (lane & 31)) * INW + (lane >> 5) * 8;
#pragma unroll
    for (int ks = 0; ks < 4; ++ks) p.q[ks] = *(const bf16x8*)(qp + ks * 16);
    p.rpb = (u.na && tid < 465) ? u.rpb[tid] : 0.f;
}
__device__ __forceinline__ void att_pre_t0(const AUnit& u, int tid, APre& p) { const bf16_t *kp, *vp; att_tile_ptrs(u, 0, tid >> 3, tid & 7, kp, vp); p.kA = *(const u32x4*)kp; p.vA = *(const u32x4*)vp; }
__device__ __forceinline__ void att_pre_t1(const AUnit& u, int tid, APre& p) { const bf16_t *kp, *vp; att_tile_ptrs(u, 1, tid >> 3, tid & 7, kp, vp); p.kB = *(const u32x4*)kp; p.vB = *(const u32x4*)vp; }
template <int VAR, bool NA> __device__ __forceinline__ void attn_unit(LAS unsigned char* lds, const AUnit& u, APre& pre, const AUnit& un, const bool has_next) {
    const int tid = opaque_v((int)threadIdx.x), lane = tid & 63, r32 = lane & 31, hh = lane >> 5; const int wid = __builtin_amdgcn_readfirstlane(tid >> 6);
    LAS float* rpbS = (LAS float*)(lds + ATT_RPB);
    bf16x8 qf[4];
#pragma unroll
    for (int ks = 0; ks < 4; ++ks) qf[ks] = pre.q[ks];
    if (NA) { if (tid < 465) rpbS[tid] = pre.rpb * LOG2E; }
    asm volatile("" :: "v"(qf[0]), "v"(qf[1]), "v"(qf[2]), "v"(qf[3]));
    const int skey = tid >> 3, sch = tid & 7, NT = u.nt0 + u.nt1;
    u32x4 kA = pre.kA, vA = pre.vA, kB = pre.kB, vB = pre.vB;
    const bf16_t *uk0 = u.k0, *uv0 = u.v0, *uk1 = u.k1 ? u.k1 : u.k0, *uv1 = u.v1 ? u.v1 : u.v0, *nk0 = un.k0, *nv0 = un.v0, *nk1 = un.k1 ? un.k1 : un.k0, *nv1 = un.v1 ? un.v1 : un.v0;
    int up0 = u.pitch0, up1 = u.pitch1, unt0 = u.nt0, np0 = un.pitch0, np1 = un.pitch1, nnt0 = un.nt0;
    asm volatile("" : "+s"(uk0), "+s"(uv0), "+s"(uk1), "+s"(uv1), "+s"(nk0), "+s"(nv0), "+s"(nk1), "+s"(nv1));
    asm volatile("" : "+s"(up0), "+s"(up1), "+s"(unt0), "+s"(np0), "+s"(np1), "+s"(nnt0));
#define ATT_LOAD(t, KR, VR, TN) do { if (VAR & 4) break; const bool own_ = (t) < NT; const bf16_t *kp_, *vp_; \
        { const int tt_ = own_ ? (t) : (TN); const int nt0_ = own_ ? unt0 : nnt0; const bool c0_ = tt_ < nt0_; const int tr_ = c0_ ? tt_ : tt_ - nt0_; \
          const bf16_t* kb_ = own_ ? (c0_ ? uk0 : uk1) : (c0_ ? nk0 : nk1); const bf16_t* vb_ = own_ ? (c0_ ? uv0 : uv1) : (c0_ ? nv0 : nv1); const int pt_ = own_ ? (c0_ ? up0 : up1) : (c0_ ? np0 : np1); \
          const size_t o_ = (size_t)(tr_ * 64 + skey) * pt_ + sch * 8; kp_ = kb_ + o_; vp_ = vb_ + o_; } \
        KR = *(const u32x4*)kp_; VR = *(const u32x4*)vp_; } while (0)
#define ATT_WRITE(b, KR, VR) do { if (VAR & 4) break; *(LAS u32x4*)(lds + ATT_K + (b) * ATT_KBUF + skey * (KP * 2) + sch * 16) = KR; *(LAS u32x4*)(lds + ATT_V + (b) * ATT_VBUF + skey * VPB + sch * 16) = VR; } while (0)
#define ATT_SYNC() do { asm volatile("s_waitcnt lgkmcnt(0)" ::: "memory"); if (!(VAR & 16)) __builtin_amdgcn_s_barrier(); asm volatile("" ::: "memory"); } while (0)
    ATT_WRITE(0, kA, vA); ATT_WRITE(1, kB, vB);
    ATT_LOAD(2, kA, vA, 0); ATT_LOAD(3, kB, vB, 1);
    ATT_SYNC();
    float mrun = 0.f, lrun = 0.f; f32x16 o0 = {}, o1 = {}, nm16 = {}; bool fresh = true;
    const int qr = u.qrow0 + (wid >> 1), qc = 32 * (wid & 1) + r32;
    const int rs = min(max(qr - 4, 0), 24), cs = min(max(qc - 8, 0), 48);
    const int vtoff = (4 * hh + ((lane & 15) >> 2)) * VPB + (16 * ((lane >> 4) & 1) + 4 * (lane & 3)) * 2;
    bf16x8 kf0[4], kf1[4];
#define ATT_KREAD(t) do { const LAS unsigned char* Kr_ = lds + ATT_K + ((t) & 3) * ATT_KBUF; \
        _Pragma("unroll") for (int ks = 0; ks < 4; ++ks) { kf0[ks] = *(const LAS bf16x8*)(Kr_ + r32 * (KP * 2) + (ks * 16 + hh * 8) * 2); kf1[ks] = *(const LAS bf16x8*)(Kr_ + (32 + r32) * (KP * 2) + (ks * 16 + hh * 8) * 2); } } while (0)
#define ATT_COMPUTE(t, KNEXT) do { \
        const bool local = NA && (t) < u.nt0; const int krow = u.krow0 + (t); \
        const bool active = !local || (krow >= rs && krow < rs + 8); \
        if (active) { \
            const LAS unsigned char* Vb = lds + ATT_V + ((t) & 3) * ATT_VBUF + vtoff; \
            f32x16 p0 = nm16, p1 = nm16; \
            __builtin_amdgcn_sched_barrier(0); \
            _Pragma("unroll") for (int ks = 0; ks < 4; ++ks) { \
                const bf16x8 a0 = kf0[ks], a1 = kf1[ks]; \
                if (VAR & 8) { p0[ks] += __builtin_bit_cast(f32x4, a0)[0]; p1[ks] += __builtin_bit_cast(f32x4, a1)[1]; } else { \
                p0 = __builtin_amdgcn_mfma_f32_32x32x16_bf16(a0, qf[ks], p0, 0, 0, 0); \
                p1 = __builtin_amdgcn_mfma_f32_32x32x16_bf16(a1, qf[ks], p1, 0, 0, 0); } } \
            if (!(VAR & 2)) { float rsum; \
              if (local) { \
                const LAS float* br = rpbS + (krow - qr + 7) * 31 + (15 - qc); \
                float b0[16], b1[16];                            \
                _Pragma("unroll") for (int i = 0; i < 16; ++i) { const int kc = (i & 3) + 8 * (i >> 2) + 4 * hh; b0[i] = br[kc]; b1[i] = br[kc + 32]; } \
                _Pragma("unroll") for (int i = 0; i < 16; ++i) asm volatile("" : "+v"(b0[i]), "+v"(b1[i])); \
                _Pragma("unroll") for (int i = 0; i < 16; ++i) { const int kc = (i & 3) + 8 * (i >> 2) + 4 * hh; \
                    { const bool ok = kc >= cs && kc < cs + 16; p0[i] = ok ? p0[i] + b0[i] : -INFINITY; } \
                    { const int kc1 = kc + 32; const bool ok = kc1 >= cs && kc1 < cs + 16; p1[i] = ok ? p1[i] + b1[i] : -INFINITY; } } } \
              float mt = __builtin_fmaxf(p0[0], p1[0]); \
              _Pragma("unroll") for (int i = 1; i < 16; ++i) mt = __builtin_fmaxf(__builtin_fmaxf(mt, p0[i]), p1[i]); \
              mt = fmaxf(mt, __shfl_xor(mt, 32));                \
              if (fresh || __any(mt > 8.0f)) {                   \
                  const float dl = fresh ? fmaxf(mt, -1e30f) : fmaxf(mt, 0.f), al = fresh ? 1.0f : fast_exp2(-dl); mrun += dl; lrun *= al; fresh = false; \
                  _Pragma("unroll") for (int i = 0; i < 16; ++i) { o0[i] *= al; o1[i] *= al; p0[i] -= dl; p1[i] -= dl; nm16[i] = -mrun; } } \
              _Pragma("unroll") for (int i = 0; i < 16; ++i) { p0[i] = fast_exp2(p0[i]); p1[i] = fast_exp2(p1[i]); } \
              { typedef float f32x2_ __attribute__((ext_vector_type(2))); f32x2_ sa = {p0[0], p0[1]}, sb = {p1[0], p1[1]}; \
                _Pragma("unroll") for (int i = 2; i < 16; i += 2) { sa += (f32x2_){p0[i], p0[i + 1]}; sb += (f32x2_){p1[i], p1[i + 1]}; } \
                sa += sb; rsum = sa[0] + sa[1]; } \
              lrun += rsum; } \
            bf16x8 pf[4]; \
            _Pragma("unroll") for (int s = 0; s < 2; ++s) { \
                u32x4 w; w.x = cvt_pk_bf16(p0[8 * s + 0], p0[8 * s + 1]); w.y = cvt_pk_bf16(p0[8 * s + 2], p0[8 * s + 3]); w.z = cvt_pk_bf16(p0[8 * s + 4], p0[8 * s + 5]); w.w = cvt_pk_bf16(p0[8 * s + 6], p0[8 * s + 7]); \
                pf[s] = __builtin_bit_cast(bf16x8, w); \
                u32x4 x; x.x = cvt_pk_bf16(p1[8 * s + 0], p1[8 * s + 1]); x.y = cvt_pk_bf16(p1[8 * s + 2], p1[8 * s + 3]); x.z = cvt_pk_bf16(p1[8 * s + 4], p1[8 * s + 5]); x.w = cvt_pk_bf16(p1[8 * s + 6], p1[8 * s + 7]); \
                pf[2 + s] = __builtin_bit_cast(bf16x8, x); } \
            __builtin_amdgcn_sched_barrier(0); \
            if ((KNEXT) >= 0) ATT_KREAD(KNEXT); \
            _Pragma("unroll") for (int s = 0; s < 4; ++s) { \
                const LAS unsigned char* vp = Vb + 16 * s * VPB; \
                { const u32x2 lo = vtr(vp), hi = vtr(vp + 8 * VPB); const u32x4 w = {lo.x, lo.y, hi.x, hi.y}; \
                  if (VAR & 8) o0[s] += __builtin_bit_cast(f32x4, w)[0] * __builtin_bit_cast(f32x4, pf[s])[1]; else o0 = __builtin_amdgcn_mfma_f32_32x32x16_bf16(__builtin_bit_cast(bf16x8, w), pf[s], o0, 0, 0, 0); } \
                { const u32x2 lo = vtr(vp + 64), hi = vtr(vp + 8 * VPB + 64); const u32x4 w = {lo.x, lo.y, hi.x, hi.y}; \
                  if (VAR & 8) o1[s] += __builtin_bit_cast(f32x4, w)[2] * __builtin_bit_cast(f32x4, pf[s])[3]; else o1 = __builtin_amdgcn_mfma_f32_32x32x16_bf16(__builtin_bit_cast(bf16x8, w), pf[s], o1, 0, 0, 0); } } \
        } else if ((KNEXT) >= 0) ATT_KREAD(KNEXT); } while (0)
    for (int t = 0; t < NT; t += 2) {
        ATT_KREAD(t);
        ATT_COMPUTE(t, (t + 1 < NT ? t + 1 : -1));
        if (t + 1 < NT) ATT_COMPUTE(t + 1, -1);
        ATT_WRITE((t + 2) & 3, kA, vA); ATT_WRITE((t + 3) & 3, kB, vB);
        ATT_LOAD(t + 4, kA, vA, 0); ATT_LOAD(t + 5, kB, vB, 1);
        ATT_SYNC();
    }
    pre.kA = kA; pre.vA = vA; pre.kB = kB; pre.vB = vB;
    att_pre_q(un, tid, pre);
    const float ltot = lrun + __shfl_xor(lrun, 32), inv = 1.0f / ltot;
    unsigned char* op = u.o + (size_t)(wid * 32 + r32) * u.opitch + 16 * hh;
    { unsigned w0[4], w1[4];
#pragma unroll
      for (int g = 0; g < 4; ++g) { w0[g] = cvt4_fp8(o0[4 * g] * inv, o0[4 * g + 1] * inv, o0[4 * g + 2] * inv, o0[4 * g + 3] * inv); w1[g] = cvt4_fp8(o1[4 * g] * inv, o1[4 * g + 1] * inv, o1[4 * g + 2] * inv, o1[4 * g + 3] * inv); }
      const unsigned ra0 = (unsigned)__shfl_xor((int)(hh ? w0[0] : w0[2]), 32), rb0 = (unsigned)__shfl_xor((int)(hh ? w0[1] : w0[3]), 32);
      const unsigned ra1 = (unsigned)__shfl_xor((int)(hh ? w1[0] : w1[2]), 32), rb1 = (unsigned)__shfl_xor((int)(hh ? w1[1] : w1[3]), 32);
      const u32x4 s0 = hh ? (u32x4){ra0, w0[2], rb0, w0[3]} : (u32x4){w0[0], ra0, w0[1], rb0};
      const u32x4 s1 = hh ? (u32x4){ra1, w1[2], rb1, w1[3]} : (u32x4){w1[0], ra1, w1[1], rb1};
      *(u32x4*)op = s0; *(u32x4*)(op + 32) = s1; }
#undef ATT_LOAD
#undef ATT_WRITE
#undef ATT_SYNC
#undef ATT_COMPUTE
#undef ATT_KREAD
}

__device__ __forceinline__ void att_make_unit(const Args& a, int l, int au, const bf16_t* BIG, unsigned char* BR, int BRW_, AUnit& u) {
        u.k1 = nullptr; u.v1 = nullptr; u.pitch1 = 0; u.nt1 = 0; u.na = 0; u.qrow0 = 0; u.krow0 = 0; u.rpb = nullptr; u.pitch0 = INW;
        if (au < 512) {
            const int b = au >> 6, h = (au >> 3) & 7, qb = au & 7; const size_t rq = (size_t)NCTX + b * 2048 + qb * 256, rk = (size_t)NCTX + b * 2048;
            u.q = BIG + rq * INW + C_GQ + h * 64; u.o = BR + rq * BRW_ + 512 + h * 64;
            u.k0 = BIG + rk * INW + C_GK + (h >> 2) * 64; u.v0 = BIG + rk * INW + C_GV + (h >> 2) * 64; u.nt0 = 32;
            const size_t co = (size_t)((b * 4 + l) * 512) * 128 + (h >> 2) * 64;
            u.k1 = (const bf16_t*)(a.ws + WS_CGK) + co; u.v1 = (const bf16_t*)(a.ws + WS_CGV) + co; u.pitch1 = 128; u.nt1 = 8;
        } else if (au < 1024) {
            const int a2 = au - 512, b = a2 >> 6, h = (a2 >> 3) & 7, rq4 = a2 & 7; const size_t rq = (size_t)NCTX + b * 2048 + rq4 * 256;
            u.q = BIG + rq * INW + C_NAQ + h * 64; u.o = BR + rq * BRW_ + h * 64;
            u.qrow0 = 4 * rq4; u.krow0 = min(max(4 * rq4 - 4, 0), 24); const int kend = min(max(4 * rq4 - 1, 0), 24) + 8; u.nt0 = kend - u.krow0;
            const size_t rk = (size_t)NCTX + b * 2048 + u.krow0 * 64;
            u.k0 = BIG + rk * INW + C_NAK + h * 64; u.v0 = BIG + rk * INW + C_NAV + h * 64;
            const size_t co = (size_t)((b * 4 + l) * 512) * 512 + h * 64;
            u.k1 = (const bf16_t*)(a.ws + WS_CNAK) + co; u.v1 = (const bf16_t*)(a.ws + WS_CNAV) + co; u.pitch1 = 512; u.nt1 = 8;
            u.na = 1; u.rpb = a.in[I_RPB] + (size_t)(l * 8 + h) * 465;
        } else {
            const int a3 = au - 1024, kind = a3 >> 8, b = (a3 & 255) >> 3, h = a3 & 7; const size_t rq = (size_t)b * 256;
            if (kind == 0) { u.q = BIG + rq * INW + C_NAQ + h * 64; u.k0 = BIG + rq * INW + C_NAK + h * 64; u.v0 = BIG + rq * INW + C_NAV + h * 64; u.o = BR + rq * BRW_ + h * 64; }
            else { u.q = BIG + rq * INW + C_GQ + h * 64; u.k0 = BIG + rq * INW + C_GK + (h >> 2) * 64; u.v0 = BIG + rq * INW + C_GV + (h >> 2) * 64; u.o = BR + rq * BRW_ + 512 + h * 64; }
            u.nt0 = 4;
        }
        u.opitch = BRW_;
}
template <int VAR> __device__ __forceinline__ void ph_attention(const Args& a, int l, LAS unsigned char* lds, int G, int bx) {
    const bf16_t* BIG = (const bf16_t*)(a.ws + WS_BIG); unsigned char* BR = VAR ? a.ws + WS_H : a.ws + WS_BR; const int BRW_ = VAR ? 1024 : BRW;
    if (bx >= 1536) return;
    const int tid0 = opaque_v((int)threadIdx.x);
    AUnit u, un; APre pre; att_make_unit(a, l, bx, BIG, BR, BRW_, u);
    att_pre_q(u, tid0, pre); att_pre_t0(u, tid0, pre); att_pre_t1(u, tid0, pre);
    for (int i = 0;; ++i) {
        const int aun = (i + 1) * G + bx; const bool has_next = aun < 1536;
        att_make_unit(a, l, has_next ? aun : bx, BIG, BR, BRW_, un);
        if (u.na) attn_unit<VAR, true>(lds, u, pre, un, has_next); else attn_unit<VAR, false>(lds, u, pre, un, has_next);
        if (!has_next) break;
        u = un;
    }
}

struct TDesc { const float* sp; unsigned char* wt; int N, K, k0, n0, mode, fp8; };
__device__ __forceinline__ void t_load(const TDesc& d, int lane, f32x4 (&w)[8]) {
    const float* p = d.sp + (size_t)(lane >> 3) * d.N + 4 * (lane & 7);
#pragma unroll
    for (int j = 0; j < 8; ++j) w[j] = __builtin_nontemporal_load((const f32x4*)(p + (size_t)(8 * j) * d.N));
}
__device__ __forceinline__ void t_lds_write(LAS float* scr, int lane, const f32x4 (&w)[8]) {
    LAS float* q = scr + (lane >> 3) * 33 + 4 * (lane & 7);
#pragma unroll
    for (int j = 0; j < 8; ++j) { q[j * 264] = w[j][0]; q[j * 264 + 1] = w[j][1]; q[j * 264 + 2] = w[j][2]; q[j * 264 + 3] = w[j][3]; }
}
__device__ __forceinline__ void t_finish(const TDesc& d, const LAS float* scr, int lane) {
    const int c = lane & 7;
#pragma unroll
    for (int j = 0; j < 4; ++j) { const int n = (lane >> 3) + 8 * j, nn = d.n0 + n; const int orow = d.mode == 0 ? nn : (((nn >> 7) << 8) + (nn & 127) + (d.mode == 2 ? 128 : 0));
        const LAS float* s = scr + (8 * c) * 33 + n;
        if (d.fp8) { u32x2 o; o.x = cvt4_fp8_sat(s[0 * 33] * W8_SCALE, s[1 * 33] * W8_SCALE, s[2 * 33] * W8_SCALE, s[3 * 33] * W8_SCALE); o.y = cvt4_fp8_sat(s[4 * 33] * W8_SCALE, s[5 * 33] * W8_SCALE, s[6 * 33] * W8_SCALE, s[7 * 33] * W8_SCALE);
            *(u32x2*)(d.wt + (size_t)orow * d.K + d.k0 + 8 * c) = o; }
        else { u32x4 o; o.x = cvt_pk_bf16(s[0 * 33], s[1 * 33]); o.y = cvt_pk_bf16(s[2 * 33], s[3 * 33]); o.z = cvt_pk_bf16(s[4 * 33], s[5 * 33]); o.w = cvt_pk_bf16(s[6 * 33], s[7 * 33]);
            *(u32x4*)((bf16_t*)d.wt + (size_t)orow * d.K + d.k0 + 8 * c) = o; } }
}
constexpr int NI_WINB = 16 * (C_F8 / 32), NI_WIN8 = 16 * (NF8 / 32), NI_WIN = NI_WINB + NI_WIN8, NI_BR = 3 * 256, NI_WO = 512, NI_E = 16 * 512, LAYER_ITEMS = NI_WIN + NI_BR + NI_WO + 3 * NI_E;
constexpr int NT_ITEMS = DEPTH * LAYER_ITEMS, NF_ITEMS = 1024, NC_ITEMS = 40960, P0_ITEMS = NT_ITEMS + NF_ITEMS + NC_ITEMS;
__device__ __forceinline__ TDesc tdesc(const Args& a, int it) {
    const int l = it / LAYER_ITEMS; int r = it - l * LAYER_ITEMS; const float* W; unsigned char* wt; int K = 1024, N = 1024, ncols = 1024, mode = 0, fp8 = 1;
    if (r < NI_WINB) { W = a.in[I_WIN] + (size_t)l * 1024 * INW; N = INW; ncols = C_F8; wt = a.ws + WS_WI + (size_t)l * INW * 1024 * 2; fp8 = 0; }
    else if ((r -= NI_WINB) < NI_WIN8) { W = a.in[I_WIN] + (size_t)l * 1024 * INW + C_F8; N = INW; ncols = NF8; wt = a.ws + WS_WI8 + (size_t)l * NF8 * 1024; }
    else if ((r -= NI_WIN8) < NI_BR) { const int n = r >> 8; r &= 255; W = a.in[I_WBR] + (size_t)(l * 4 + n) * 512 * 1024; K = 512; wt = a.ws + WS_WBR + (size_t)(l * 4 + n) * 1024 * 512; }
    else if ((r -= NI_BR) < NI_WO) { W = a.in[I_WOUT] + (size_t)l * 1024 * 1024; wt = a.ws + WS_WO + (size_t)l * 1024 * 1024 * 2; fp8 = 0; }
    else { r -= NI_WO; const int which = r / NI_E; r -= which * NI_E; const int e = r >> 9; r &= 511; const size_t le = (size_t)(l * 16 + e);
        if (which == 0) { W = a.in[I_WG] + le * 1048576; wt = a.ws + WS_WGU8 + le * 2097152; mode = 1; }
        else if (which == 1) { W = a.in[I_WU] + le * 1048576; wt = a.ws + WS_WGU8 + le * 2097152; mode = 2; }
        else { W = a.in[I_WDN] + le * 1048576; wt = a.ws + WS_WD8 + le * 1048576; } }
    const int nblk = ncols >> 5, kb = r / nblk, nb = r - kb * nblk;
    TDesc d; d.sp = W + (size_t)(kb << 6) * N + (nb << 5); d.wt = wt; d.N = N; d.K = K; d.k0 = kb << 6; d.n0 = nb << 5; d.mode = mode; d.fp8 = fp8; return d;
}
constexpr int EARLY = NI_WIN + NI_BR + NI_WO;
#ifndef SLICE_A
#define SLICE_A 8000
#define SLICE_B 11500
#define SLICE_C 6000
#endif
constexpr int OFF_A = 0, OFF_B = SLICE_A, OFF_C = SLICE_A + SLICE_B, OFF_T = SLICE_A + SLICE_B + SLICE_C, SLICE_T = LAYER_ITEMS - OFF_T;
static_assert(SLICE_T >= 0 && SLICE_T <= 10000, "slices");
__device__ __forceinline__ void conv_loop(const Args& a, LAS float* scr, int lane, int j0, int jstep, int count, int base) {
    int j = j0; TDesc d{}; f32x4 w[8];
    if (j < count) { d = tdesc(a, base + j); t_load(d, lane, w); }
    while (j < count) {
        t_lds_write(scr, lane, w);
        const int jn = j + jstep; TDesc dn = d;
        if (jn < count) { dn = tdesc(a, base + jn); t_load(dn, lane, w); }
        LDS_WAIT();
        t_finish(d, scr, lane);
        LDS_WAIT();
        d = dn; j = jn; }
}

__device__ __forceinline__ void ph_prologue(const Args& a, LAS unsigned char* lds, int G, int bx, int tid, int wave, int lane) {
    { const int gt = bx * 512 + tid;
      if (gt < 1024) { const int pos = gt >> 4, f = gt & 15; const double invd = exp10(-(double)f * 0.25);
          const float ang = (float)pos * (float)invd; const double x = (double)ang;
          const double k = rint(x * 0.15915494309189535); const double r = fma(-k, 6.283185307179586, x) - k * 2.4492935982947064e-16;
          const double r2 = r * r; double ts = r, ss = r, tc = 1.0, sc = 1.0;
          for (int q = 1; q <= 14; ++q) { ts *= -r2 / (double)((2 * q) * (2 * q + 1)); ss += ts; tc *= -r2 / (double)((2 * q - 1) * (2 * q)); sc += tc; }
          float* rt = (float*)(a.ws + WS_ROPE); rt[2 * gt] = (float)sc; rt[2 * gt + 1] = (float)ss; ((unsigned*)(a.ws + WS_ROPE + 8192))[gt] = cvt_pk_f16((float)sc, (float)ss); } }
    if (bx < 384) {
        LAS float* sil = (LAS float*)lds; LAS float* part = (LAS float*)(lds + 36864);
        for (int i = tid; i < 9 * 1024; i += 512) { const int r = i >> 10, d = i & 1023; const float cv = r == 0 ? a.in[I_CCTX][d] : a.in[I_C][(r - 1) * 1024 + d]; sil[i] = cv * sigmoidf_(cv); }
        __syncthreads();
        for (int it = bx; it < 384; it += G) { const int l = it / 96, cg = it - l * 96;
            float acc[9];
#pragma unroll
            for (int r = 0; r < 9; ++r) acc[r] = 0.f;
            const float* wp = a.in[I_WADA] + ((size_t)l * 1024 + wave * 128) * 6144 + cg * 64 + lane;
#pragma unroll 32
            for (int d = 0; d < 128; ++d) { const float wv = wp[(size_t)d * 6144];
#pragma unroll
                for (int r = 0; r < 9; ++r) acc[r] += sil[r * 1024 + wave * 128 + d] * wv; }
#pragma unroll
            for (int r = 0; r < 9; ++r) part[(wave * 9 + r) * 64 + lane] = acc[r];
            __syncthreads();
            for (int i = tid; i < 576; i += 512) { const int r = i >> 6, col = i & 63; float s = a.in[I_BADA][l * 6144 + cg * 64 + col];
#pragma unroll
                for (int w = 0; w < 8; ++w) s += part[(w * 9 + r) * 64 + col];
                ((float*)(a.ws + WS_MOD))[(size_t)(l * 9 + r) * 6144 + cg * 64 + col] = s; }
            __syncthreads();
        }
    }
    __syncthreads();
    LAS float* scr = (LAS float*)(lds + wave * 16384);
    const int gw = bx * 8 + wave, NGW = G * 8;
    conv_loop(a, scr, lane, gw, NGW, EARLY, 0);
    for (int r = gw; r < NF_ITEMS; r += NGW) {
            const int l = r >> 8, g = (r >> 6) & 3, cb = (r >> 4) & 3, db = r & 15, c0 = cb * 32, d0 = db * 64;
            const float* pw = a.in[I_POOLW] + ((size_t)(l * 4 + g) * 128 + c0) * 128;
#pragma unroll 16
            for (int q = 0; q < 64; ++q) scr[lane + 64 * q] = pw[lane + 64 * q];
            LDS_WAIT();
            float acc[32];
#pragma unroll
            for (int ci = 0; ci < 32; ++ci) acc[ci] = 0.f;
            const float* wb = a.in[I_WBR] + ((size_t)(l * 4 + 3) * 512 + g * 128) * 1024 + d0 + lane; const float* ps = a.in[I_POOLS] + l * 512 + g * 128;
#pragma unroll 16
            for (int j = 0; j < 128; ++j) { const float wv = wb[(size_t)j * 1024] * ps[j];
#pragma unroll
                for (int ci = 0; ci < 32; ++ci) acc[ci] += scr[ci * 128 + j] * wv; }
            unsigned char* o = a.ws + WS_WBR + ((size_t)(l * 4 + 3) * 1024 + d0 + lane) * 512 + g * 128 + c0;
#pragma unroll
            for (int q = 0; q < 4; ++q) { u32x2 w; w.x = cvt4_fp8_sat(acc[8 * q] * W8_SCALE, acc[8 * q + 1] * W8_SCALE, acc[8 * q + 2] * W8_SCALE, acc[8 * q + 3] * W8_SCALE); w.y = cvt4_fp8_sat(acc[8 * q + 4] * W8_SCALE, acc[8 * q + 5] * W8_SCALE, acc[8 * q + 6] * W8_SCALE, acc[8 * q + 7] * W8_SCALE);
                *(u32x2*)(o + 8 * q) = w; }
            LDS_WAIT();
    }
    for (int it = gw; it < NC_ITEMS; it += 5 * NGW) { f32x4 x0[5], x1[5]; bf16_t* dp[5];
#pragma unroll
        for (int u = 0; u < 5; ++u) { int r = min(it + u * NGW, NC_ITEMS - 1); const float* src; bf16_t* dst;
            if (r < 16384) { src = a.in[I_CNAK]; dst = (bf16_t*)(a.ws + WS_CNAK); }
            else if (r < 32768) { r -= 16384; src = a.in[I_CNAV]; dst = (bf16_t*)(a.ws + WS_CNAV); }
            else if (r < 36864) { r -= 32768; src = a.in[I_CGK]; dst = (bf16_t*)(a.ws + WS_CGK); }
            else { r -= 36864; src = a.in[I_CGV]; dst = (bf16_t*)(a.ws + WS_CGV); }
            const size_t e0 = (size_t)r * 512 + lane * 8; x0[u] = *(const f32x4*)(src + e0); x1[u] = *(const f32x4*)(src + e0 + 4); dp[u] = dst + e0; }
#pragma unroll
        for (int u = 0; u < 5; ++u) { u32x4 w; w.x = cvt_pk_bf16(x0[u][0], x0[u][1]); w.y = cvt_pk_bf16(x0[u][2], x0[u][3]); w.z = cvt_pk_bf16(x1[u][0], x1[u][1]); w.w = cvt_pk_bf16(x1[u][2], x1[u][3]);
            *(u32x4*)dp[u] = w; } }
}

__device__ __forceinline__ float sum16(float v) { v += __shfl_xor(v, 1); v += __shfl_xor(v, 2); v += __shfl_xor(v, 4); v += __shfl_xor(v, 8); return v; }
__device__ __forceinline__ float sum32(float v) { v = sum16(v); v += __shfl_xor(v, 16); return v; }
__device__ __forceinline__ void ph_x(const Args& a, int l, LAS unsigned char* lds, int tid, int gw, int NGW, int lane) {
    const float* mod = (const float*)(a.ws + WS_MOD); bf16_t* H = (bf16_t*)(a.ws + WS_H);
    const int* slot = (const int*)(a.ws + WS_SLOT); const float* aff = (const float*)(a.ws + WS_AFF); const unsigned char* YE = a.ws + WS_YE;
    LAS f32x4* V4 = (LAS f32x4*)lds;
    { f32x4 fv[16];
#pragma unroll
      for (int k = 0; k < 16; ++k) { const int vec = 2 * k + (tid >> 8), u = tid & 255, mr = min((vec - 2) / 3, 8), w = (vec - 2) - 3 * ((vec - 2) / 3);
          const float* src = vec >= 29 ? (l > 0 ? (vec == 29 ? a.in[I_LN1G] : a.in[I_LN1B]) + (l - 1) * 1024 : mod) : vec < 2 ? (l > 0 ? (vec == 0 ? a.in[I_LN2G] : a.in[I_LN2B]) + (l - 1) * 1024 : mod)
                                     : (w == 0 ? (l > 0 ? mod + (size_t)((l - 1) * 9 + mr) * 6144 + 5 * 1024 : mod) : (l < DEPTH ? mod + (size_t)(l * 9 + mr) * 6144 + (w - 1) * 1024 : mod));
          fv[k] = *(const f32x4*)(src + 4 * u); }
#pragma unroll
      for (int k = 0; k < 16; ++k) { const int vec = 2 * k + (tid >> 8), u = tid & 255; V4[vec * 256 + ((u >> 6) * 2 + (u & 1)) * 32 + ((u & 63) >> 1)] = fv[k]; } }
    __syncthreads();
    const int s = lane & 31, r = lane >> 5;
#define XV(vec, c, h) V4[(vec) * 256 + (2 * (c) + (h)) * 32 + s]
    u32x4 xw[4]; int sl = -1; float af = 0.f; f32x2_t st = {0.f, 1.f};
    { const int tok = gw * 2 + r;
      if (l > 0 && gw * 2 < NTOK) { const bf16_t* xb = (const bf16_t*)(a.ws + WS_V) + (size_t)tok * D + 8 * s; st = *(const f32x2_t*)(a.ws + WS_STATS + (size_t)tok * 8);
#pragma unroll
          for (int c = 0; c < 4; ++c) xw[c] = *(const u32x4*)(xb + 256 * c);
          if (s < 16) { sl = slot[(size_t)s * NTOK + tok]; af = aff[tok * 16 + s]; } } }
    for (int t0 = gw * 2; t0 < NTOK; t0 += NGW * 2) {
        const int tok = t0 + r, mr = modrow_of_tok(tok); float* xo = a.out + (size_t)tok * D + 8 * s; bf16_t* xb = (bf16_t*)(a.ws + WS_XB) + (size_t)tok * D + 8 * s; f32x4 x[8];
        if (l == 0) { const float* xi = (tok < NCTX ? a.in[I_XP] + (size_t)tok * D : a.in[I_XS] + (size_t)(tok - NCTX) * D) + 8 * s;
#pragma unroll
            for (int c = 0; c < 4; ++c) { x[2 * c] = *(const f32x4*)(xi + 256 * c); x[2 * c + 1] = *(const f32x4*)(xi + 256 * c + 4); }
        } else {
            const u32x4 xc[4] = {xw[0], xw[1], xw[2], xw[3]}; const int slc = sl; const float afc = af; const f32x2_t stc = st;
            { const int tn = t0 + NGW * 2;
              if (tn < NTOK) { const int tk = tn + r; const bf16_t* xn = (const bf16_t*)(a.ws + WS_V) + (size_t)tk * D + 8 * s; st = *(const f32x2_t*)(a.ws + WS_STATS + (size_t)tk * 8);
#pragma unroll
                  for (int c = 0; c < 4; ++c) xw[c] = *(const u32x4*)(xn + 256 * c);
                  if (s < 16) { sl = slot[(size_t)s * NTOK + tk]; af = aff[tk * 16 + s]; } } }
            f32x4 acc[8];
#pragma unroll
            for (int j = 0; j < 8; ++j) acc[j] = (f32x4){0.f, 0.f, 0.f, 0.f};
            unsigned m = (unsigned)(__ballot(slc >= 0) >> (32 * r)) & 0xffffu;
            const int ebase = tok < NCTX ? 0 : 16384, ecap = tok < NCTX ? 1024 : 2048;
            while (__any(m != 0u)) {
                u32x2 yw[4][4]; float g[4];
#pragma unroll
                for (int j = 0; j < 4; ++j) { const bool valid = m != 0u; const int e = valid ? __builtin_ctz(m) : 0; m &= m - 1u;
                    const int si = __shfl(slc, (lane & 32) + e); g[j] = valid ? __shfl(afc, (lane & 32) + e) * (1.0f / 16.0f) : 0.f;
                    const unsigned char* yr = YE + (size_t)(ebase + e * ecap + (valid ? si : 0)) * D + 8 * s;
#pragma unroll
                    for (int c = 0; c < 4; ++c) yw[j][c] = *(const u32x2*)(yr + 256 * c); }
#pragma unroll
                for (int j = 0; j < 4; ++j)
#pragma unroll
                    for (int c = 0; c < 4; ++c) { float y8[8]; fp8x8_to_f32(yw[j][c], y8);
                        acc[2 * c][0] += g[j] * y8[0]; acc[2 * c][1] += g[j] * y8[1]; acc[2 * c][2] += g[j] * y8[2]; acc[2 * c][3] += g[j] * y8[3];
                        acc[2 * c + 1][0] += g[j] * y8[4]; acc[2 * c + 1][1] += g[j] * y8[5]; acc[2 * c + 1][2] += g[j] * y8[6]; acc[2 * c + 1][3] += g[j] * y8[7]; }
            }
            float s1 = 0.f; asm volatile("" ::: "memory");
#pragma unroll
            for (int c = 0; c < 4; ++c) { const u32x4 w = xc[c];
                x[2 * c] = ((f32x4){h16lo(w.x), h16hi(w.x), h16lo(w.y), h16hi(w.y)} - stc[0]) * stc[1] * XV(29, c, 0) + XV(30, c, 0);
                x[2 * c + 1] = ((f32x4){h16lo(w.z), h16hi(w.z), h16lo(w.w), h16hi(w.w)} - stc[0]) * stc[1] * XV(29, c, 1) + XV(30, c, 1); }
#pragma unroll
            for (int c = 0; c < 4; ++c)
#pragma unroll
                for (int h = 0; h < 2; ++h) { const int j = 2 * c + h; const f32x4 g2 = XV(2 + 3 * mr, c, h); x[j] = ALPHA * x[j] + g2 * acc[j]; s1 += (x[j][0] + x[j][1]) + (x[j][2] + x[j][3]); }
            const float mean = sum32(s1) * (1.f / D); float s2 = 0.f;
#pragma unroll
            for (int j = 0; j < 8; ++j) { x[j] = x[j] - mean; s2 += (x[j][0] * x[j][0] + x[j][1] * x[j][1]) + (x[j][2] * x[j][2] + x[j][3] * x[j][3]); }
            const float rstd = 1.0f / sqrtf(sum32(s2) * (1.f / D) + 1e-6f); asm volatile("" ::: "memory");
#pragma unroll
            for (int c = 0; c < 4; ++c)
#pragma unroll
                for (int h = 0; h < 2; ++h) { const int j = 2 * c + h; x[j] = x[j] * rstd * XV(0, c, h) + XV(1, c, h); }
        }
        if (l == DEPTH) {
#pragma unroll
            for (int c = 0; c < 4; ++c) { *(f32x4*)(xo + 256 * c) = x[2 * c]; *(f32x4*)(xo + 256 * c + 4) = x[2 * c + 1]; } }
        else {
#pragma unroll
            for (int c = 0; c < 4; ++c) { u32x4 w; w.x = cvt_pk_f16(x[2 * c][0], x[2 * c][1]); w.y = cvt_pk_f16(x[2 * c][2], x[2 * c][3]); w.z = cvt_pk_f16(x[2 * c + 1][0], x[2 * c + 1][1]); w.w = cvt_pk_f16(x[2 * c + 1][2], x[2 * c + 1][3]); *(u32x4*)(xb + 256 * c) = w; } }
        if (l < DEPTH) { bf16_t* ho = H + (size_t)tok * D + 8 * s; unsigned char* ho8 = a.ws + WS_H8 + (size_t)tok * D + 8 * s;
#pragma unroll
            for (int c = 0; c < 4; ++c) { asm volatile("" ::: "memory"); const f32x4 h0 = x[2 * c] * (1.0f + XV(4 + 3 * mr, c, 0)) + XV(3 + 3 * mr, c, 0), h1 = x[2 * c + 1] * (1.0f + XV(4 + 3 * mr, c, 1)) + XV(3 + 3 * mr, c, 1);
                u32x4 w; w.x = cvt_pk_bf16(h0[0], h0[1]); w.y = cvt_pk_bf16(h0[2], h0[3]); w.z = cvt_pk_bf16(h1[0], h1[1]); w.w = cvt_pk_bf16(h1[2], h1[3]); *(u32x4*)(ho + 256 * c) = w;
                u32x2 w8; w8.x = cvt4_fp8_sat(h0[0], h0[1], h0[2], h0[3]); w8.y = cvt4_fp8_sat(h1[0], h1[1], h1[2], h1[3]); *(u32x2*)(ho8 + 256 * c) = w8; } }
    }
#undef XV
}

__device__ __forceinline__ void bf8_unpack(u32x4 w, float (&v)[8]) { v[0] = bflo(w.x); v[1] = bfhi(w.x); v[2] = bflo(w.y); v[3] = bfhi(w.y); v[4] = bflo(w.z); v[5] = bfhi(w.z); v[6] = bflo(w.w); v[7] = bfhi(w.w); }
__device__ __forceinline__ void ph_thin(const Args& a, int l, int gw, int NGW, int lane) {
    bf16_t* BIG = (bf16_t*)(a.ws + WS_BIG); unsigned char* BR = a.ws + WS_BR; const unsigned* rope = (const unsigned*)(a.ws + WS_ROPE + 8192);
    const int sub = lane & 7, quarter = sub >> 1, c0 = 8 * lane, half0 = 1 << (lane >> 4), lk = lane & 15; const bf16_t* zrow = (const bf16_t*)(a.ws + WS_ZERO) + c0; const char* zb = (const char*)(a.ws + WS_ZERO);
    for (int q = gw; q < NTOK / 4; q += NGW) {
        const int tok0 = 4 * q; const bool lat = tok0 >= NCTX; const int t0 = lat ? ((tok0 - NCTX) & 2047) : (tok0 & 255), L = lat ? 2048 : 256;
        bf16_t* row0 = BIG + (size_t)tok0 * INW; const int half = opaque_v(half0);
        const unsigned ob = (unsigned)(WS_BIG - WS_ZERO) + (unsigned)(tok0 - half) * (unsigned)(INW * 2) + (unsigned)((C_PLU + c0) * 2), zo = 2u * c0;
#define POOL_LD(idx, ok) (*(const u32x4*)(zb + ((ok) ? ob + (unsigned)(idx) * (unsigned)(INW * 2) : zo)))
        u32x4 wq[4], wk[4], rp[4][2];
#pragma unroll
        for (int k = 0; k < 4; ++k) { wq[k] = *(const u32x4*)(row0 + (size_t)k * INW + C_GQ + 8 * lane); wk[k] = *(const u32x4*)(row0 + (size_t)k * INW + C_GK + 8 * lk); }
        const f32x4 gq0 = *(const f32x4*)(a.in[I_QNG] + l * 64 + 8 * sub), gq1 = *(const f32x4*)(a.in[I_QNG] + l * 64 + 8 * sub + 4);
        const f32x4 gk0 = *(const f32x4*)(a.in[I_KNG] + l * 64 + 8 * sub), gk1 = *(const f32x4*)(a.in[I_KNG] + l * 64 + 8 * sub + 4);
        if (lat) {
#pragma unroll
            for (int k = 0; k < 4; ++k) { const int pos = quarter < 2 ? (t0 >> 6) : ((t0 & 63) + k); const unsigned* r_ = rope + pos * 16 + (sub & 1) * 8; rp[k][0] = *(const u32x4*)r_; rp[k][1] = *(const u32x4*)(r_ + 4); } }
#pragma unroll
        for (int pass = 0; pass < 2; ++pass) {
            const float gw8[8] = {pass ? gk0[0] : gq0[0] * C2, pass ? gk0[1] : gq0[1] * C2, pass ? gk0[2] : gq0[2] * C2, pass ? gk0[3] : gq0[3] * C2, pass ? gk1[0] : gq1[0] * C2, pass ? gk1[1] : gq1[1] * C2, pass ? gk1[2] : gq1[2] * C2, pass ? gk1[3] : gq1[3] * C2};
#pragma unroll
            for (int k = 0; k < 4; ++k) { const int t = t0 + k; float x[8]; bf8_unpack(pass ? wk[k] : wq[k], x);
                float ss = 0.f;
#pragma unroll
                for (int i = 0; i < 8; ++i) ss += x[i] * x[i];
                ss += __shfl_xor(ss, 1); ss += __shfl_xor(ss, 2); ss += __shfl_xor(ss, 4);
                const float rn = 1.0f / sqrtf(ss * (1.f / 64.f) + 1e-6f);
#pragma unroll
                for (int i = 0; i < 8; ++i) x[i] = x[i] * rn * gw8[i];
                if (lat) {
#pragma unroll
                    for (int i = 0; i < 8; ++i) { const float pr = __shfl_xor(x[i], 2); const unsigned cs_ = rp[k][i >> 2][i & 3]; const float cs = h16lo(cs_), sn = h16hi(cs_);
                        x[i] = (quarter & 1) ? (pr * sn + x[i] * cs) : (x[i] * cs - pr * sn); } }
                u32x4 o; o.x = cvt_pk_bf16(x[0], x[1]); o.y = cvt_pk_bf16(x[2], x[3]); o.z = cvt_pk_bf16(x[4], x[5]); o.w = cvt_pk_bf16(x[6], x[7]);
                if (pass == 0) *(u32x4*)(row0 + (size_t)k * INW + C_GQ + 8 * lane) = o;
                else if (lane < 16) { *(u32x4*)(row0 + (size_t)k * INW + C_GK + 8 * lane) = o;
                    if (!lat) { float* so = a.out + O_SGK + ((size_t)((tok0 >> 8) * 4 + l) * 256 + t) * 128 + 8 * lane; *(f32x4*)so = (f32x4){x[0], x[1], x[2], x[3]}; *(f32x4*)(so + 4) = (f32x4){x[4], x[5], x[6], x[7]}; } } }
        }
        asm volatile("" ::: "memory");
        u32x4 cw[6], hw[6], bw[4];
#pragma unroll
        for (int rr = 0; rr < 6; ++rr) { const int tt = t0 - 1 + rr; const bool ok = tt >= 0 && tt < L; const bf16_t* p = ok ? row0 + (ptrdiff_t)(rr - 1) * INW + C_CVC + c0 : zrow; cw[rr] = *(const u32x4*)p; hw[rr] = *(const u32x4*)(ok ? p + (C_CVH - C_CVC) : zrow); }
#pragma unroll
        for (int k = 0; k < 4; ++k) bw[k] = *(const u32x4*)(row0 + (size_t)k * INW + C_CVB + c0);
        const float* cb = a.in[I_CONVB] + l * 512 + c0; const float* wk_ = a.in[I_CONVW] + (size_t)l * 3 * 512 + c0;
        const f32x4 cwt[8] = {*(const f32x4*)wk_, *(const f32x4*)(wk_ + 4), *(const f32x4*)(wk_ + 512), *(const f32x4*)(wk_ + 516), *(const f32x4*)(wk_ + 1024), *(const f32x4*)(wk_ + 1028), *(const f32x4*)cb, *(const f32x4*)(cb + 4)};
        u32x4 pa[8];
#pragma unroll
        for (int i = 0; i < 8; ++i) pa[i] = POOL_LD(i, i < 2 * half && t0 - half + i >= 0);
        { float u[6][8];
#pragma unroll
          for (int rr = 0; rr < 6; ++rr) { const int tt = t0 - 1 + rr; float c_[8], h_[8]; bf8_unpack(cw[rr], c_); bf8_unpack(hw[rr], h_);
#pragma unroll
              for (int i = 0; i < 8; ++i) u[rr][i] = c_[i] * h_[i]; }
#pragma unroll
          for (int k = 0; k < 4; ++k) { float b_[8], y[8]; bf8_unpack(bw[k], b_);
#pragma unroll
              for (int i = 0; i < 8; ++i) y[i] = b_[i] * (cwt[6 + (i >> 2)][i & 3] + cwt[i >> 2][i & 3] * u[k][i] + cwt[2 + (i >> 2)][i & 3] * u[k + 1][i] + cwt[4 + (i >> 2)][i & 3] * u[k + 2][i]);
              u32x2 o; o.x = cvt4_fp8_sat(y[0], y[1], y[2], y[3]); o.y = cvt4_fp8_sat(y[4], y[5], y[6], y[7]);
              *(u32x2*)(BR + (size_t)(tok0 + k) * BRW + 1024 + c0) = o; } }
        asm volatile("" ::: "memory");
        { u32x4 pb[8];
#pragma unroll
          for (int i = 0; i < 8; ++i) pb[i] = POOL_LD(8 + i, 8 + i < 2 * half && t0 - half + 8 + i < L);
          float S[8];
#pragma unroll
          for (int j = 0; j < 8; ++j) S[j] = 0.f;
#pragma unroll
          for (int i = 0; i < 8; ++i) { float v[8]; bf8_unpack(pa[i], v);
#pragma unroll
              for (int j = 0; j < 8; ++j) S[j] += v[j]; }
          asm volatile("" ::: "memory");
          u32x4 ph[3], pt[3], po[4];
#pragma unroll
          for (int j = 0; j < 3; ++j) { ph[j] = POOL_LD(j, t0 - half + j >= 0); pt[j] = POOL_LD(2 * half + j, t0 + half + j < L); }
#pragma unroll
          for (int k = 0; k < 4; ++k) po[k] = POOL_LD(half + k, true);
#pragma unroll
          for (int i = 0; i < 8; ++i) { float v[8]; bf8_unpack(pb[i], v);
#pragma unroll
              for (int j = 0; j < 8; ++j) S[j] += v[j]; }
#pragma unroll
          for (int k = 0; k < 4; ++k) { const int t = t0 + k; const float ic = 1.0f / (float)(min(t + half, L) - max(t - half, 0)); float own[8]; bf8_unpack(po[k], own);
              u32x2 o; o.x = cvt4_fp8_sat(S[0] * ic - own[0], S[1] * ic - own[1], S[2] * ic - own[2], S[3] * ic - own[3]); o.y = cvt4_fp8_sat(S[4] * ic - own[4], S[5] * ic - own[5], S[6] * ic - own[6], S[7] * ic - own[7]);
              *(u32x2*)(BR + (size_t)(tok0 + k) * BRW + 1536 + c0) = o;
              if (k < 3) { float vh[8], vt[8]; bf8_unpack(ph[k], vh); bf8_unpack(pt[k], vt);
#pragma unroll
                  for (int j = 0; j < 8; ++j) S[j] += vt[j] - vh[j]; } } }
    }
}

#undef POOL_LD
__device__ __forceinline__ void ph_ln1(const Args& a, int l, LAS unsigned char* lds, int tid, int gw, int NGW, int lane) {
    LAS float* wrT = (LAS float*)lds;
    LAS float* gS = wrT + 16384; LAS float* bS = gS + 1024;
    { const f32x4* src = (const f32x4*)(a.in[I_WR] + (size_t)l * 1024 * 16); f32x4 w[8];
#pragma unroll
      for (int j = 0; j < 8; ++j) w[j] = src[tid + 512 * j];
      const f32x4 gb = *(const f32x4*)((tid < 256 ? a.in[I_LN1G] : a.in[I_LN1B]) + l * 1024 + 4 * (tid & 255));
#pragma unroll
      for (int j = 0; j < 8; ++j) { const int q = tid + 512 * j, k = q >> 2, e0 = (q & 3) * 4, pk = (k >> 9) * 512 + ((k >> 2) & 1) * 256 + ((k >> 3) & 63) * 4 + (k & 3);
#pragma unroll
          for (int i = 0; i < 4; ++i) wrT[(e0 + i) * 1024 + pk] = w[j][i]; }
      { const int k = 4 * (tid & 255), pk = (k >> 9) * 512 + ((k >> 2) & 1) * 256 + ((k >> 3) & 63) * 4; *(LAS f32x4*)((tid < 256 ? gS : bS) + pk) = gb; } }
    __syncthreads();
    const float* mod = (const float*)(a.ws + WS_MOD); const bf16_t* V = (const bf16_t*)(a.ws + WS_V); unsigned char* H8 = a.ws + WS_H8;
    float* aff = (float*)(a.ws + WS_AFF); float* afft = (float*)(a.ws + WS_AFFT);
    u32x4 vw[4][2];
    if (gw < NTOK / 4) {
#pragma unroll
        for (int t = 0; t < 4; ++t)
#pragma unroll
            for (int c = 0; c < 2; ++c) vw[t][c] = *(const u32x4*)((const char*)(V + (size_t)(4 * gw + t) * D + 512 * c) + (unsigned)(16 * lane)); }
    for (int q = gw; q < NTOK / 4; q += NGW) {
        const int t0 = 4 * q; const char* mp = (const char*)(mod + (size_t)(l * 9 + modrow_of_tok(t0)) * 6144);
        f32x4 msc[2][2], msh[2][2];
#pragma unroll
        for (int c = 0; c < 2; ++c)
#pragma unroll
            for (int h = 0; h < 2; ++h) { msc[c][h] = *(const f32x4*)(mp + (4 * 1024 + 512 * c + 4 * h) * 4 + (unsigned)(32 * lane)); msh[c][h] = *(const f32x4*)(mp + (3 * 1024 + 512 * c + 4 * h) * 4 + (unsigned)(32 * lane)); }
        float v[4][2][8];
#pragma unroll
        for (int t = 0; t < 4; ++t)
#pragma unroll
            for (int c = 0; c < 2; ++c) { const u32x4 w = vw[t][c]; v[t][c][0] = h16lo(w.x); v[t][c][1] = h16hi(w.x); v[t][c][2] = h16lo(w.y); v[t][c][3] = h16hi(w.y); v[t][c][4] = h16lo(w.z); v[t][c][5] = h16hi(w.z); v[t][c][6] = h16lo(w.w); v[t][c][7] = h16hi(w.w); }
        { const int qn = q + NGW;
          if (qn < NTOK / 4) {
#pragma unroll
              for (int t = 0; t < 4; ++t)
#pragma unroll
                  for (int c = 0; c < 2; ++c) vw[t][c] = *(const u32x4*)((const char*)(V + (size_t)(4 * qn + t) * D + 512 * c) + (unsigned)(16 * lane)); } }
        float rstd[4], mean4[4];
#pragma unroll
        for (int t = 0; t < 4; ++t) { float s1 = 0.f;
#pragma unroll
            for (int c = 0; c < 2; ++c)
#pragma unroll
                for (int i = 0; i < 8; i += 4) s1 += (v[t][c][i] + v[t][c][i + 1]) + (v[t][c][i + 2] + v[t][c][i + 3]);
            const float mean = wave_sum(s1) * (1.f / D); float s2 = 0.f;
#pragma unroll
            for (int c = 0; c < 2; ++c)
#pragma unroll
                for (int i = 0; i < 8; ++i) { v[t][c][i] -= mean; s2 += v[t][c][i] * v[t][c][i]; }
            rstd[t] = 1.0f / sqrtf(wave_sum(s2) * (1.f / D) + 1e-6f); mean4[t] = mean; }
        if (lane < 4) { const float mm = lane == 0 ? mean4[0] : lane == 1 ? mean4[1] : lane == 2 ? mean4[2] : mean4[3], rr = lane == 0 ? rstd[0] : lane == 1 ? rstd[1] : lane == 2 ? rstd[2] : rstd[3];
            *(f32x2_t*)(a.ws + WS_STATS + (size_t)(t0 + lane) * 8) = (f32x2_t){mm, rr}; }
#pragma unroll
        for (int c = 0; c < 2; ++c) {
#pragma unroll
            for (int h = 0; h < 2; ++h) { const f32x4 g4 = *(const LAS f32x4*)(gS + c * 512 + h * 256 + 4 * lane), b4 = *(const LAS f32x4*)(bS + c * 512 + h * 256 + 4 * lane);
#pragma unroll
                for (int t = 0; t < 4; ++t)
#pragma unroll
                    for (int i = 0; i < 4; ++i) { const float x1 = v[t][c][4 * h + i] * rstd[t] * g4[i] + b4[i]; v[t][c][4 * h + i] = x1 * (1.0f + msc[c][h][i]) + msh[c][h][i]; } }
#pragma unroll
            for (int t = 0; t < 4; ++t) { const size_t o = (size_t)(t0 + t) * D + 512 * c;
                u32x2 w8; w8.x = cvt4_fp8_sat(v[t][c][0], v[t][c][1], v[t][c][2], v[t][c][3]); w8.y = cvt4_fp8_sat(v[t][c][4], v[t][c][5], v[t][c][6], v[t][c][7]); *(u32x2*)((char*)(H8 + o) + (unsigned)(8 * lane)) = w8; } }
        float p[64];
#pragma unroll
        for (int j = 0; j < 64; ++j) p[j] = 0.f;
#pragma unroll
        for (int c = 0; c < 2; ++c)
#pragma unroll
            for (int e = 0; e < 16; ++e) { const f32x4 w0 = *(const LAS f32x4*)(wrT + e * 1024 + c * 512 + 4 * lane), w1 = *(const LAS f32x4*)(wrT + e * 1024 + c * 512 + 256 + 4 * lane);
#pragma unroll
                for (int t = 0; t < 4; ++t) p[t * 16 + e] += (v[t][c][0] * w0[0] + v[t][c][1] * w0[1]) + (v[t][c][2] * w0[2] + v[t][c][3] * w0[3]) + (v[t][c][4] * w1[0] + v[t][c][5] * w1[1]) + (v[t][c][6] * w1[2] + v[t][c][7] * w1[3]);
                if ((e & 1) == 1) asm volatile("" ::: "memory"); }
#pragma unroll
        for (int j = 0; j < 32; ++j) { const auto r_ = __builtin_amdgcn_permlane32_swap(__float_as_uint(p[j]), __float_as_uint(p[j + 32]), false, false); p[j] = __uint_as_float(r_[0]) + __uint_as_float(r_[1]); }
#pragma unroll
        for (int j = 0; j < 16; ++j) { const auto r_ = __builtin_amdgcn_permlane16_swap(__float_as_uint(p[j]), __float_as_uint(p[j + 16]), false, false); p[j] = __uint_as_float(r_[0]) + __uint_as_float(r_[1]); }
#pragma unroll
        for (int n = 8; n >= 1; n >>= 1) { const bool up = (lane & n) != 0;
#pragma unroll
            for (int j = 0; j < n; ++j) { const float keep = up ? p[j + n] : p[j], send = up ? p[j] : p[j + n]; p[j] = keep + __shfl_xor(send, n); } }
        const float z = p[0]; float mx = z;
#pragma unroll
        for (int o = 1; o < 16; o <<= 1) mx = fmaxf(mx, __shfl_xor(mx, o));
        const float ez = expf(z - mx); const float mine = ez / sum16(ez);
        aff[t0 * 16 + lane] = mine; afft[(size_t)(lane & 15) * NTOK + t0 + (lane >> 4)] = mine;
    }
}

__device__ __forceinline__ int block_excl_scan(int v, LAS int* sc, int tid, int& total) {
    const int lane = tid & 63, w = tid >> 6; int inc = v;
#pragma unroll
    for (int o = 1; o < 64; o <<= 1) { const int t = __shfl_up(inc, o); if (lane >= o) inc += t; }
    if (lane == 63) sc[w] = inc;
    __syncthreads();
    int off = 0, tot = 0;
#pragma unroll
    for (int i = 0; i < 8; ++i) { const int s = sc[i]; off += (i < w) ? s : 0; tot += s; }
    __syncthreads();
    total = tot; return off + inc - v;
}
__device__ __forceinline__ void ph_topk(const Args& a, LAS unsigned char* lds, int G, int bx, int tid) {
    LAS unsigned* keys = (LAS unsigned*)lds; LAS unsigned* hist = keys + 16384 + 512; LAS int* sc = (LAS int*)(hist + 4096); LAS unsigned* bc = (LAS unsigned*)(sc + 16);
    const float* afft = (const float*)(a.ws + WS_AFFT); int* slot = (int*)(a.ws + WS_SLOT); int* idx = (int*)(a.ws + WS_IDX);
    const int lane = tid & 63;
#define KIDX(j) ((j) + ((j) >> 5))
    for (int prob = bx; prob < 32; prob += G) {
        const bool lat = prob >= 16; const int e = prob & 15, n = lat ? NLAT : NCTX, cap = n >> 3, tbase = lat ? NCTX : 0, lbase = lat ? 16384 + e * 2048 : e * 1024;
        { const f32x4* kp = (const f32x4*)(afft + (size_t)e * NTOK + tbase); f32x4 kv[8];
#pragma unroll
          for (int u = 0; u < 8; ++u) { const int i4 = tid + 512 * u; kv[u] = i4 * 4 < n ? kp[i4] : (f32x4){0.f, 0.f, 0.f, 0.f}; }
#pragma unroll
          for (int u = 0; u < 8; ++u) { const int i = 4 * (tid + 512 * u); if (i < n) { keys[KIDX(i)] = __float_as_uint(kv[u][0]); keys[KIDX(i + 1)] = __float_as_uint(kv[u][1]); keys[KIDX(i + 2)] = __float_as_uint(kv[u][2]); keys[KIDX(i + 3)] = __float_as_uint(kv[u][3]); } } }
        unsigned prefix = 0u, mask = 0u; int krem = cap;
#pragma unroll 1
        for (int pass = 0; pass < 3; ++pass) { const int shift = pass == 0 ? 20 : pass == 1 ? 10 : 0, nbin = pass == 0 ? 4096 : 1024;
            for (int i = tid; i < nbin; i += 512) hist[i] = 0u;
            __syncthreads();
            for (int i = tid; i < n; i += 512) { const unsigned k = keys[KIDX(i)]; if ((k & mask) == prefix) atomicAdd((unsigned*)&hist[(k >> shift) & (unsigned)(nbin - 1)], 1u); }
            __syncthreads();
            if (tid < 64) { const int per = nbin >> 6; unsigned s = 0u;
                for (int b = 0; b < per; ++b) s += hist[per * lane + b];
                unsigned suf = s;
#pragma unroll
                for (int o = 1; o < 64; o <<= 1) { const unsigned t = __shfl_down(suf, o); if (lane + o < 64) suf += t; }
                unsigned cum = suf - s;
                if (cum < (unsigned)krem && cum + s >= (unsigned)krem) {
                    for (int b = per - 1; b >= 0; --b) { const unsigned c = hist[per * lane + b]; if (cum + c >= (unsigned)krem) { bc[0] = prefix | ((unsigned)(per * lane + b) << shift); bc[1] = (unsigned)krem - cum; break; } cum += c; } } }
            __syncthreads();
            prefix = bc[0]; krem = (int)bc[1]; mask |= (unsigned)(nbin - 1) << shift;
            __syncthreads();
        }
        const unsigned T = prefix; const int C = n >> 9, i0 = tid * C; int ceq = 0;
        for (int i = 0; i < C; ++i) ceq += (keys[KIDX(i0 + i)] == T) ? 1 : 0;
        int tot; int er = block_excl_scan(ceq, sc, tid, tot); int csel = 0; { int e2 = er;
            for (int i = 0; i < C; ++i) { const unsigned k = keys[KIDX(i0 + i)]; const bool sel = k > T || (k == T && e2 < krem); e2 += (k == T) ? 1 : 0; csel += sel ? 1 : 0; } }
        int so = block_excl_scan(csel, sc, tid, tot);
        for (int i = 0; i < C; ++i) { const unsigned k = keys[KIDX(i0 + i)]; const bool sel = k > T || (k == T && er < krem); er += (k == T) ? 1 : 0;
            keys[KIDX(i0 + i)] = sel ? (unsigned)so : 0xffffffffu; if (sel) { idx[lbase + so] = tbase + i0 + i; ++so; } }
        __syncthreads();
        for (int i = tid; i < n; i += 512) slot[(size_t)e * NTOK + tbase + i] = (int)keys[KIDX(i)];
        __syncthreads();
    }
#undef KIDX
}

__device__ __forceinline__ Args load_args() {
#if defined(__HIP_DEVICE_COMPILE__)
    const __attribute__((address_space(4))) unsigned char* p = (const __attribute__((address_space(4))) unsigned char*)__builtin_amdgcn_kernarg_segment_ptr(); asm volatile("" : "+s"(p));
    return *(const __attribute__((address_space(4))) Args*)p;
#else
    return Args{};
#endif
}
#define PH_VIEW() const Args a = load_args(); const int tid = opaque_v((int)threadIdx.x), lane = tid & 63, wave = __builtin_amdgcn_readfirstlane(tid >> 6); \
    const int G = opaque_s((int)gridDim.x), bx = opaque_s((int)blockIdx.x), gw = bx * 8 + wave, NGW = G * 8; LAS unsigned char* lds = (LAS unsigned char*)smem; (void)lane; (void)wave; (void)gw; (void)NGW; (void)lds; (void)tid
constexpr int N_PHASES = 2 + 10 * DEPTH;
#ifndef PH_MASK
#define PH_MASK 0xFFFF
#endif
#define PHON(j) (((PH_MASK) >> (j)) & 1)
#ifndef ATT_SHADOW
#define ATT_SHADOW 0
#endif
#ifndef XCD_STAGGER
#define XCD_STAGGER 0
#endif
#ifndef XCD_STAGGER2
#define XCD_STAGGER2 0
#endif
#ifndef REP_MASK
#define REP_MASK 0
#endif
#define NREP(j) (1 + (((REP_MASK) >> (j)) & 1))
__global__ void __launch_bounds__(512, 2) mk_fwd(Args a_) {
    extern __shared__ __attribute__((aligned(16))) unsigned char smem[];
    { volatile LAS unsigned* MISC = (volatile LAS unsigned*)((LAS unsigned char*)smem + MISC_OFF);
      if (threadIdx.x < 32) MISC[threadIdx.x] = 0u;
      __syncthreads();
      (void)xcd_barrier_post((unsigned*)(a_.ws + WS_CTL) + CW_BAR, MISC + 8); }
    const int lo = a_.ph_lo, hi = a_.ph_hi;
#define STAGGER(step) do { if (step) { const unsigned long long t0_ = __builtin_amdgcn_s_memrealtime(), dt_ = (unsigned long long)((xb_xcc_id() & 7u) * (step)); while (__builtin_amdgcn_s_memrealtime() - t0_ < dt_) __builtin_amdgcn_s_sleep(8); } } while (0)
#define IN(k) (lo <= (k) && (k) < hi)
#define SEAM(k) do { if (IN(k) && IN((k) + 1)) { const Args sa = load_args(); XcdBarrier b; b.bar = (unsigned*)(sa.ws + WS_CTL) + CW_BAR; b.x = xb_xcc_id(); b.st = (volatile LAS unsigned*)((LAS unsigned char*)smem + MISC_OFF) + 8; xcd_barrier(b); } } while (0)
#define SEAMF() do { const Args sa = load_args(); XcdBarrier b; b.bar = (unsigned*)(sa.ws + WS_CTL) + CW_BAR; b.x = xb_xcc_id(); b.st = (volatile LAS unsigned*)((LAS unsigned char*)smem + MISC_OFF) + 8; xcd_barrier(b); } while (0)
#define SLACK_CONV(nwg, off, cap) do { const int base_ = EARLY + l * LAYER_ITEMS + (off), cnt_ = min((cap), NT_ITEMS - base_), f_ = (nwg) % G; if (cnt_ > 0 && bx >= f_) conv_loop(a, (LAS float*)(lds + wave * 16384), lane, (bx - f_) * 8 + wave, (G - f_) * 8, cnt_, base_); } while (0)
    if (PHON(10) && IN(0)) for (int rep_ = 0; rep_ < NREP(10); ++rep_) { if (rep_) { SEAMF(); } { PH_VIEW(); ph_prologue(a, lds, G, bx, tid, wave, lane); } }
    SEAM(0);
    for (int l = 0; l < DEPTH; ++l) {
        const int pb = 1 + 10 * l;
        if (PHON(0) && IN(pb + 0)) { PH_VIEW(); ph_x(a, l, lds, tid, gw, NGW, lane); }
        SEAM(pb + 0);
        if (PHON(1) && IN(pb + 1)) for (int rep_ = 0; rep_ < NREP(1); ++rep_) { if (rep_) { SEAMF(); } { PH_VIEW(); STAGGER(XCD_STAGGER);
            { pg8::SchedLin S{G, bx, 96, C_F8 / 256, 1, (const char*)(a.ws + WS_H), (const char*)(a.ws + WS_WI) + (size_t)l * INW * 1024 * 2, 1024, 1024, 0, 0};
              pg8::EpiWin E{(bf16_t*)(a.ws + WS_BIG), a.out, l}; pg8::gemm_phase(lds, 1024, S, E); }
            { pg8::SchedLin S{G, bx, 96, NF8 / 256, 1, (const char*)(a.ws + WS_H8), (const char*)(a.ws + WS_WI8) + (size_t)l * NF8 * 1024, 512, 512, 0, 0};
              pg8::EpiWinGate E{(bf16_t*)(a.ws + WS_BIG)}; pg8::gemm_phase(lds, 512, S, E); }
            SLACK_CONV(96 * (C_F8 / 256), OFF_A, SLICE_A); } }
        SEAM(pb + 1);
        if (PHON(2) && IN(pb + 2)) { PH_VIEW(); ph_thin(a, l, gw, NGW, lane); }
        SEAM(pb + 2);
        if (PHON(3) && IN(pb + 3)) for (int rep_ = 0; rep_ < NREP(3); ++rep_) { if (rep_) { SEAMF(); } { PH_VIEW(); ph_attention<0>(a, l, lds, G, bx); if (ATT_SHADOW) ph_attention<ATT_SHADOW>(a, l, lds, G, bx); } }
        SEAM(pb + 3);
        if (PHON(4) && IN(pb + 4)) for (int rep_ = 0; rep_ < NREP(4); ++rep_) { if (rep_) { SEAMF(); } { PH_VIEW(); STAGGER(XCD_STAGGER2); pg8::SchedLin S{G, bx, 96, 4, 4, (const char*)(a.ws + WS_BR), (const char*)(a.ws + WS_WBR) + (size_t)l * 4 * 1024 * 512, BRW / 2, 256, 512, (size_t)1024 * 512};
            pg8::EpiBranch E{(const bf16_t*)(a.ws + WS_BIG), (bf16_t*)(a.ws + WS_MRG)}; pg8::gemm_phase(lds, 256, S, E); SLACK_CONV(96 * 4, OFF_B, SLICE_B); } }
        SEAM(pb + 4);
        if (PHON(5) && IN(pb + 5)) for (int rep_ = 0; rep_ < NREP(5); ++rep_) { if (rep_) { SEAMF(); } { PH_VIEW(); STAGGER(XCD_STAGGER2); pg8::SchedLin S{G, bx, 96, 4, 1, (const char*)(a.ws + WS_MRG), (const char*)(a.ws + WS_WO) + (size_t)l * 1024 * 1024 * 2, 1024, 1024, 0, 0};
            pg8::EpiWout E{(const bf16_t*)(a.ws + WS_XB), (const float*)(a.ws + WS_MOD) + (size_t)l * 9 * 6144, (bf16_t*)(a.ws + WS_V)}; pg8::gemm_phase(lds, 1024, S, E); SLACK_CONV(96 * 4, OFF_C, SLICE_C); } }
        SEAM(pb + 5);
        if (PHON(6) && IN(pb + 6)) for (int rep_ = 0; rep_ < NREP(6); ++rep_) { if (rep_) { SEAMF(); } { PH_VIEW(); ph_ln1(a, l, lds, tid, gw, NGW, lane); } }
        SEAM(pb + 6);
        if (PHON(7) && IN(pb + 7)) for (int rep_ = 0; rep_ < NREP(7); ++rep_) { if (rep_) { SEAMF(); } { PH_VIEW(); ph_topk(a, lds, G, bx, tid);
            { const int cb0 = G > 32 ? 32 : 0, base_ = EARLY + l * LAYER_ITEMS + OFF_T, cnt_ = min(SLICE_T, NT_ITEMS - base_); if (cnt_ > 0 && bx >= cb0) conv_loop(a, (LAS float*)(lds + wave * 16384), lane, (bx - cb0) * 8 + wave, (G - cb0) * 8, cnt_, base_); } } }
        SEAM(pb + 7);
        if (PHON(8) && IN(pb + 8)) for (int rep_ = 0; rep_ < NREP(8); ++rep_) { if (rep_) { SEAMF(); } { PH_VIEW(); STAGGER(XCD_STAGGER2); pg8::SchedGU S{G, bx, (const char*)(a.ws + WS_H8), (const char*)(a.ws + WS_WGU8) + (size_t)l * 16 * 2048 * 1024, (const int*)(a.ws + WS_IDX)};
            pg8::EpiGU E{a.ws + WS_HDN}; pg8::gemm_phase(lds, 512, S, E); } }
        SEAM(pb + 8);
        if (PHON(9) && IN(pb + 9)) for (int rep_ = 0; rep_ < NREP(9); ++rep_) { if (rep_) { SEAMF(); } { PH_VIEW(); STAGGER(XCD_STAGGER2); pg8::SchedDown S{G, bx, (const char*)(a.ws + WS_HDN), (const char*)(a.ws + WS_WD8) + (size_t)l * 16 * 1024 * 1024};
            pg8::EpiDown E{a.ws + WS_YE}; pg8::gemm_phase(lds, 512, S, E); } }
        SEAM(pb + 9);
    }
    if (PHON(0) && IN(N_PHASES - 1)) { PH_VIEW(); ph_x(a, DEPTH, lds, tid, gw, NGW, lane); }
#undef IN
#undef SEAM
}

extern "C" void kernel_launch(void* const* d_in, const int* in_sizes, int n_in, void* d_out, int out_size, void* d_ws, size_t ws_size, hipStream_t stream) {
    static int grid = 0;
    if (grid == 0) {
        if (n_in != 28 || (size_t)out_size != O_END || ws_size < WS_END) { fprintf(stderr, "kernel_launch: unexpected problem (n_in %d, out %d, ws %zu); nothing launched\n", n_in, out_size, ws_size); grid = -1; return; }
        int dev = 0, cus = 0, per_cu = 0;
        if (hipGetDevice(&dev) != hipSuccess || hipDeviceGetAttribute(&cus, hipDeviceAttributeMultiprocessorCount, dev) != hipSuccess) { grid = -1; return; }
        if (hipFuncSetAttribute((const void*)mk_fwd, hipFuncAttributeMaxDynamicSharedMemorySize, LDS_BYTES) != hipSuccess) { fprintf(stderr, "kernel_launch: hipFuncSetAttribute failed\n"); grid = -1; return; }
        if (hipOccupancyMaxActiveBlocksPerMultiprocessor(&per_cu, (const void*)mk_fwd, 512, LDS_BYTES) != hipSuccess || per_cu < 1) { fprintf(stderr, "kernel_launch: occupancy query reports %d blocks per CU\n", per_cu); }
        (void)hipGetLastError();
        grid = cus;
    }
    if (grid < 0) return;
    (void)hipMemsetAsync((char*)d_ws + WS_CTL, 0, CTL_BYTES, stream);
    Args a{};
    for (int i = 0; i < 28; ++i) a.in[i] = (const float*)d_in[i];
    a.out = (float*)d_out; a.ws = (unsigned char*)d_ws;
#if MK_ONE_LAUNCH
    a.ph_lo = 0; a.ph_hi = N_PHASES;
    hipLaunchKernelGGL(mk_fwd, dim3(grid), dim3(512), LDS_BYTES, stream, a);
#else
    for (int p = 0; p < N_PHASES; ++p) { a.ph_lo = p; a.ph_hi = p + 1; hipLaunchKernelGGL(mk_fwd, dim3(grid), dim3(512), LDS_BYTES, stream, a); }
#endif
}
```

```cpp
#include <hip/hip_runtime.h>
#include <cstdio>
#include <cstdint>

#ifndef MK_ONE_LAUNCH
#define MK_ONE_LAUNCH 1
#endif

#define LAS __attribute__((address_space(3)))
typedef unsigned short bf16_t;
typedef short bf16x8 __attribute__((ext_vector_type(8)));
typedef float f32x4 __attribute__((ext_vector_type(4)));
typedef float f32x16 __attribute__((ext_vector_type(16)));
typedef unsigned u32x4 __attribute__((ext_vector_type(4)));
typedef unsigned u32x2 __attribute__((ext_vector_type(2)));

constexpr int D = 1024, NCTX = 8192, NLAT = 16384, NTOK = 24576, DEPTH = 4, INW = 8448;
constexpr int C_NAQ = 0, C_NAK = 512, C_NAV = 1024, C_GQ = 1536, C_GK = 2048, C_GV = 2176, C_CVB = 2304, C_CVC = 2816, C_CVH = 3328, C_PLU = 3840, C_GATE = 4352;
#ifndef C_F8_START
#define C_F8_START C_GATE
#endif
constexpr int C_F8 = C_F8_START, NF8 = INW - C_F8;
constexpr int BRW = 2048;
constexpr float ALPHA = 1.6817928305074290f;
constexpr float LOG2E = 1.4426950408889634f;
constexpr float C2 = 0.125f * 1.4426950408889634f;
constexpr size_t O_X = 0, O_SNAK = (size_t)NTOK * D, O_SNAV = O_SNAK + 16777216, O_SGK = O_SNAV + 16777216, O_SGV = O_SGK + 4194304, O_END = O_SGV + 4194304;
constexpr size_t MiB = 1u << 20;
constexpr size_t WS_CTL = 0, CTL_BYTES = 1 * MiB;
constexpr size_t WS_MOD = 1 * MiB;
constexpr size_t WS_ROPE = 2 * MiB - 16384;
constexpr size_t WS_AFF = 2 * MiB, WS_AFFT = WS_AFF + 1572864, WS_SLOT = WS_AFFT + 1572864, WS_IDX = WS_SLOT + 1572864;
constexpr size_t WS_STATS = 7 * MiB;
constexpr size_t WS_WI = 8 * MiB, WS_WBR = 74 * MiB, WS_WO = 90 * MiB;
constexpr size_t WS_WGU8 = 98 * MiB, WS_WD8 = 226 * MiB, WS_WI8 = 290 * MiB, WS_H8 = 320 * MiB;
constexpr size_t WS_CNAK = 482 * MiB, WS_CNAV = 498 * MiB, WS_CGK = 514 * MiB, WS_CGV = 518 * MiB;
constexpr size_t WS_H = 522 * MiB, WS_BIG = 570 * MiB, WS_V = WS_BIG, WS_HDN = WS_BIG + 96 * MiB, WS_YE = WS_BIG + 192 * MiB;
constexpr size_t WS_BR = 966 * MiB, WS_MRG = 1062 * MiB, WS_XB = 1110 * MiB, WS_END = 1158 * MiB;
static_assert(WS_IDX + 49152 * 4 <= WS_WI && WS_BIG + (size_t)NTOK * INW * 2 <= WS_BR, "ws map");
constexpr int CW_BAR = 4096;
constexpr size_t WS_ZERO = WS_CTL + 512 * 1024;
constexpr int RING_BYTES = 131072, MISC_OFF = RING_BYTES + 320, LDS_BYTES = 147456;

struct Args { const float* in[28]; float* out; unsigned char* ws; int ph_lo, ph_hi; };
enum { I_XP = 0, I_XS, I_CNAK, I_CNAV, I_CGK, I_CGV, I_C, I_CCTX, I_WADA, I_BADA, I_WIN, I_RPB, I_QNG, I_KNG, I_CONVW, I_CONVB, I_POOLW, I_POOLS, I_WBR, I_WOUT, I_LN1G, I_LN1B, I_LN2G, I_LN2B, I_WR, I_WG, I_WU, I_WDN };

#define LDS_WAIT() asm volatile("s_waitcnt lgkmcnt(0)" ::: "memory")
__device__ __forceinline__ unsigned cvt_pk_bf16(float lo, float hi) { unsigned r; asm("v_cvt_pk_bf16_f32 %0, %1, %2" : "=v"(r) : "v"(lo), "v"(hi)); return r; }
typedef _Float16 h16x2 __attribute__((ext_vector_type(2)));
__device__ __forceinline__ unsigned cvt_pk_f16(float lo, float hi) { const h16x2 v = {(_Float16)lo, (_Float16)hi}; return __builtin_bit_cast(unsigned, v); }
__device__ __forceinline__ float h16lo(unsigned w) { return (float)__builtin_bit_cast(h16x2, w)[0]; }
__device__ __forceinline__ float h16hi(unsigned w) { return (float)__builtin_bit_cast(h16x2, w)[1]; }
__device__ __forceinline__ unsigned cvt4_fp8(float a, float b, float c, float d) { int w = 0; w = __builtin_amdgcn_cvt_pk_fp8_f32(a, b, w, false); w = __builtin_amdgcn_cvt_pk_fp8_f32(c, d, w, true); return (unsigned)w; }
typedef float f32x2_t __attribute__((ext_vector_type(2)));
__device__ __forceinline__ void fp8x8_to_f32(u32x2 w, float (&o)[8]) { const f32x2_t a = __builtin_amdgcn_cvt_pk_f32_fp8((int)w.x, false), b = __builtin_amdgcn_cvt_pk_f32_fp8((int)w.x, true), c = __builtin_amdgcn_cvt_pk_f32_fp8((int)w.y, false), d = __builtin_amdgcn_cvt_pk_f32_fp8((int)w.y, true);
    o[0] = a[0]; o[1] = a[1]; o[2] = b[0]; o[3] = b[1]; o[4] = c[0]; o[5] = c[1]; o[6] = d[0]; o[7] = d[1]; }
__device__ __forceinline__ unsigned pack4_u8(float a, float b, float c, float d) { unsigned w = 0u; w = __builtin_amdgcn_cvt_pk_u8_f32(a, 0, w); w = __builtin_amdgcn_cvt_pk_u8_f32(b, 1, w); w = __builtin_amdgcn_cvt_pk_u8_f32(c, 2, w); w = __builtin_amdgcn_cvt_pk_u8_f32(d, 3, w); return w; }
__device__ __forceinline__ void u8x8_to_f32(u32x2 w, float (&o)[8]) { o[0] = (float)(w.x & 0xffu); o[1] = (float)((w.x >> 8) & 0xffu); o[2] = (float)((w.x >> 16) & 0xffu); o[3] = (float)(w.x >> 24);
    o[4] = (float)(w.y & 0xffu); o[5] = (float)((w.y >> 8) & 0xffu); o[6] = (float)((w.y >> 16) & 0xffu); o[7] = (float)(w.y >> 24); }
__device__ __forceinline__ float sat448(float v) { return __builtin_amdgcn_fmed3f(v, -448.0f, 448.0f); }
__device__ __forceinline__ unsigned cvt4_fp8_sat(float a, float b, float c, float d) { return cvt4_fp8(sat448(a), sat448(b), sat448(c), sat448(d)); }
constexpr float W8_SCALE = 64.0f;
__device__ __forceinline__ float bflo(unsigned w) { return __uint_as_float(w << 16); }
__device__ __forceinline__ float bfhi(unsigned w) { return __uint_as_float(w & 0xffff0000u); }
__device__ __forceinline__ int opaque_v(int v) { asm volatile("" : "+v"(v)); return v; }
__device__ __forceinline__ int opaque_s(int v) { v = __builtin_amdgcn_readfirstlane(v); asm volatile("" : "+s"(v)); return v; }
__device__ __forceinline__ float wave_sum(float v) {
#pragma unroll
    for (int o = 1; o < 64; o <<= 1) v += __shfl_xor(v, o);
    return v;
}
__device__ __forceinline__ float fast_exp2(float x) { return __builtin_amdgcn_exp2f(x); }
__device__ __forceinline__ float sigmoidf_(float z) { return __builtin_amdgcn_rcpf(1.0f + fast_exp2(-z * LOG2E)); }
__device__ __forceinline__ int modrow_of_tok(int tok) { return tok < NCTX ? 0 : 1 + ((tok - NCTX) >> 11); }

#define XB_TMO      128
#define XB_XCNT(j)  (256  + 64 * (j))
#define XB_XSUB(j)  (1280 + 64 * (j))
#define XB_XGEN(j)  (2304 + 64 * (j))
#define XB_TOP      3328
#define XB_TOPGEN   3392
#define XCD_BAR_WORDS 3456
#define XB_SPIN_CAP (1u << 18)
__device__ __forceinline__ unsigned xb_ld(unsigned* p)              { return __hip_atomic_load(p, __ATOMIC_RELAXED, __HIP_MEMORY_SCOPE_AGENT); }
__device__ __forceinline__ unsigned xb_add(unsigned* p, unsigned v) { return __hip_atomic_fetch_add(p, v, __ATOMIC_RELAXED, __HIP_MEMORY_SCOPE_AGENT); }
__device__ __forceinline__ unsigned xb_xcc_id() { return (unsigned)__builtin_amdgcn_s_getreg((3 << 11) | 20) & 0xFu; }
#define XB_SPIN(cond, bar) do { unsigned _sp = 0; while (cond) { __builtin_amdgcn_s_sleep(1); \
    if ((++_sp & 255u) == 0u) { if (xb_ld(&(bar)[XB_TMO])) break; if (_sp > XB_SPIN_CAP) { atomicAdd(&(bar)[XB_TMO], 1u); break; } } } } while (0)
struct XcdBarrier { unsigned* bar; unsigned x; volatile LAS unsigned* st; };
__device__ __forceinline__ XcdBarrier xcd_barrier_post(unsigned* bar, volatile LAS unsigned* st) {
    XcdBarrier b; b.bar = bar; b.x = xb_xcc_id(); b.st = st;
    if (threadIdx.x == 0) (void)xb_add(&bar[XB_XCNT(b.x)], 1u);
    return b;
}
__device__ __forceinline__ void xcd_barrier_complete(unsigned* bar, unsigned x, unsigned& nloc, unsigned& nx) {
    const unsigned G = gridDim.x * gridDim.y * gridDim.z;
    unsigned sum, cnt, mine, sp = 0u;
    for (;;) {
        sum = 0u; cnt = 0u; mine = 0u;
#pragma unroll
        for (unsigned j = 0; j < 16; ++j) { const unsigned c = xb_ld(&bar[XB_XCNT(j)]); sum += c; cnt += (c > 0u) ? 1u : 0u; mine = (j == x) ? c : mine; }
        if (sum == G) break;
        __builtin_amdgcn_s_sleep(1);
        if ((++sp & 255u) == 0u) { if (xb_ld(&bar[XB_TMO])) break; if (sp > XB_SPIN_CAP) { atomicAdd(&bar[XB_TMO], 1u); break; } }
    }
    nloc = mine > 0u ? mine : 1u; nx = cnt > 0u ? cnt : 1u;
}
__device__ __forceinline__ void xcd_barrier(const XcdBarrier& b) {
    asm volatile("s_waitcnt vmcnt(0)" ::: "memory");
    __syncthreads();
    if (threadIdx.x == 0) {
        unsigned* bar = b.bar;
        __builtin_amdgcn_s_waitcnt(0);
        unsigned nloc = b.st[0], nx = b.st[1];
        if (nloc == 0u) { xcd_barrier_complete(bar, b.x, nloc, nx); b.st[0] = nloc; b.st[1] = nx; }
        const unsigned old = xb_add(&bar[XB_XSUB(b.x)], 1u);
        const unsigned gen = old / nloc;
        if (old + 1u == (gen + 1u) * nloc) {
            __builtin_amdgcn_fence(__ATOMIC_RELEASE, "agent");
            asm volatile("s_waitcnt vmcnt(0)" ::: "memory");
            const unsigned og = xb_add(&bar[XB_TOP], 1u);
            const unsigned tg = og / nx;
            if (og + 1u == (tg + 1u) * nx) xb_add(&bar[XB_TOPGEN], 1u);
            else XB_SPIN(xb_ld(&bar[XB_TOPGEN]) == tg, bar);
            __builtin_amdgcn_fence(__ATOMIC_ACQUIRE, "agent");
            xb_add(&bar[XB_XGEN(b.x)], 1u);
            asm volatile("s_waitcnt vmcnt(0)" ::: "memory");
        } else {
            XB_SPIN(xb_ld(&bar[XB_XGEN(b.x)]) == gen, bar);
            __builtin_amdgcn_fence(__ATOMIC_ACQUIRE, "agent");
            asm volatile("s_waitcnt vmcnt(0)" ::: "memory");
        }
    }
    __syncthreads();
}

#ifndef PG8_WGM
#define PG8_WGM 8
#endif
#ifndef PG8_ALIGN_EPI
#define PG8_ALIGN_EPI 1
#endif
namespace pg8 {
constexpr int BM = 256, BK = 64, HALF = 128, HTB = HALF * BK * 2, STAGE_BYTES = 8 * HTB;
__device__ __forceinline__ int lds_byte(int r, int c) { const int st = (r >> 4) * 2 + (c >> 5), rr = r & 15, cc = c & 31, ob = rr * 64 + cc * 2; return st * 1024 + (ob ^ (((ob >> 9) & 1) << 5)); }
__device__ __forceinline__ void stage_rc(int b, int& R, int& C) { const int st = b / 1024, sb = b % 1024, swz = sb ^ (((sb >> 9) & 1) << 5); R = (st >> 1) * 16 + swz / 64; C = (st & 1) * 32 + (swz % 64) / 2; }
__device__ __forceinline__ int perm32(int rho) { const int n = rho >> 4, i = rho & 15; return 8 * (i >> 2) + 4 * n + (i & 3); }
__device__ __forceinline__ int xcd_remap(int L, int nwg) { const int q = nwg >> 3, r = nwg & 7, xcd = L & 7, off = L >> 3; return (xcd < r ? xcd * (q + 1) : r * (q + 1) + (xcd - r) * q) + off; }

struct GUnit { const char* A; const char* B; int pm, pn, aux, rowbase; };

template <class Epi, class Sched>
__device__ __forceinline__ void gemm_phase(LAS unsigned char* lds, const int K, const Sched& S, const Epi& E) {
    const int tid = opaque_v((int)threadIdx.x), wid = __builtin_amdgcn_readfirstlane(tid >> 6), lane = tid & 63, wr = wid >> 2, wc = wid & 3, fr = lane & 15, fq = lane >> 4;
    const int nt = K / BK;
    int sR[2], sC[2]; unsigned voffB[2];
#pragma unroll
    for (int i = 0; i < 2; ++i) { int R, C; stage_rc(tid * 16 + i * 8192, R, C); const int Rb = Epi::PERM ? ((R & ~31) + perm32(R & 31)) : R; sR[i] = R; sC[i] = C; voffB[i] = (unsigned)(Rb * K + C) * 2u; }
    const size_t kstep = (size_t)(BK * 2);
    const size_t hstep = (size_t)HALF * K * 2;
    const unsigned ldsw = (unsigned)wid * 1024u;
    const int aoff = lds_byte(wr * 64 + fr, fq * 8), boff = lds_byte(wc * 32 + fr, fq * 8);
#define PG8_SA(b, h) (((b) * 2 + (h)) * HTB)
#define PG8_SB(b, h) ((4 + (b) * 2 + (h)) * HTB)
#define PG8_STAGE(bufoff, gbase, v0, v1) do { \
        __builtin_amdgcn_global_load_lds((const unsigned*)((const char*)(gbase) + (v0)), (LAS unsigned*)(lds + (bufoff) + ldsw), 16, 0, 0); \
        __builtin_amdgcn_global_load_lds((const unsigned*)((const char*)(gbase) + (v1)), (LAS unsigned*)(lds + (bufoff) + ldsw + 8192), 16, 0, 0); } while (0)
#define PG8_STAGE_B(bufoff, gbase) PG8_STAGE(bufoff, gbase, voffB[0], voffB[1])
#define PG8_LDA(dst, b, h) do { _Pragma("unroll") for (int m = 0; m < 4; ++m) _Pragma("unroll") for (int k = 0; k < 2; ++k) dst[m][k] = *(const LAS bf16x8*)(lds + PG8_SA(b, h) + aoff + m * 2048 + k * 1024); } while (0)
#define PG8_LDB(dst, b, h) do { _Pragma("unroll") for (int n = 0; n < 2; ++n) _Pragma("unroll") for (int k = 0; k < 2; ++k) dst[n][k] = *(const LAS bf16x8*)(lds + PG8_SB(b, h) + boff + n * 2048 + k * 1024); } while (0)
#define PG8_MMA(ai, bj, At, Bt) do { __builtin_amdgcn_s_setprio(1); _Pragma("unroll") for (int m = 0; m < 4; ++m) _Pragma("unroll") for (int n = 0; n < 2; ++n) { \
        if constexpr (Epi::FP8) { typedef int v4i_ __attribute__((ext_vector_type(4))); typedef int v8i_ __attribute__((ext_vector_type(8))); \
            const v8i_ wf = __builtin_shufflevector(__builtin_bit_cast(v4i_, Bt[n][0]), __builtin_bit_cast(v4i_, Bt[n][1]), 0, 1, 2, 3, 4, 5, 6, 7); \
            const v8i_ af = __builtin_shufflevector(__builtin_bit_cast(v4i_, At[m][0]), __builtin_bit_cast(v4i_, At[m][1]), 0, 1, 2, 3, 4, 5, 6, 7); \
            asm volatile("v_mfma_scale_f32_16x16x128_f8f6f4 %0, %1, %2, %0, %3, %4 op_sel_hi:[0,0,0]" : "+v"(acc[ai][bj][m][n]) : "v"(wf), "v"(af), "v"(scl_w), "v"(scl_a)); \
        } else { _Pragma("unroll") for (int k = 0; k < 2; ++k) acc[ai][bj][m][n] = __builtin_amdgcn_mfma_f32_16x16x32_bf16(Bt[n][k], At[m][k], acc[ai][bj][m][n], 0, 0, 0); } } \
        __builtin_amdgcn_s_setprio(0); } while (0)
#define PG8_WAIT_V(n) asm volatile("s_waitcnt vmcnt(" #n ")" ::: "memory")
#define PG8_WAIT_L(n) asm volatile("s_waitcnt lgkmcnt(" #n ")" ::: "memory")
#define PG8_BAR __builtin_amdgcn_s_barrier()
#define PG8_SCHED __builtin_amdgcn_sched_barrier(0)
    GUnit cur, nxt; int ui = 0;
    if (!S.next(0, cur)) return;
    const int scl_w = 0x79797979, scl_a = 0x7f7f7f7f;
    (void)scl_w; (void)scl_a;
    f32x4 acc[2][2][4][2];
#pragma unroll
    for (int a = 0; a < 2; ++a)
#pragma unroll
        for (int b = 0; b < 2; ++b)
#pragma unroll
            for (int m = 0; m < 4; ++m)
#pragma unroll
                for (int n = 0; n < 2; ++n) acc[a][b][m][n] = (f32x4){0.f, 0.f, 0.f, 0.f};
    bf16x8 At[4][2], B0[2][2], B1[2][2];
    unsigned vA00, vA01, vA10, vA11, vN00 = 0, vN01 = 0, vN10 = 0, vN11 = 0;
    vA00 = S.a_off(cur, sR[0], sC[0]); vA01 = S.a_off(cur, sR[1], sC[1]);
    if constexpr (Sched::GATHER) { vA10 = S.a_off(cur, HALF + sR[0], sC[0]); vA11 = S.a_off(cur, HALF + sR[1], sC[1]); } else { vA10 = vA00; vA11 = vA01; }
    const size_t hA = Sched::GATHER ? (size_t)0 : S.a_hstep();
    const char* cA = cur.A; const char* cB = cur.B;
    PG8_STAGE_B(PG8_SB(0, 0), cB); PG8_STAGE_B(PG8_SB(0, 1), cB + hstep); PG8_STAGE(PG8_SA(0, 0), cA, vA00, vA01); PG8_STAGE(PG8_SA(0, 1), cA + hA, vA10, vA11);
    if (wr == 1) PG8_BAR;
    PG8_WAIT_V(2); PG8_BAR;
    PG8_STAGE_B(PG8_SB(1, 0), cB + kstep); PG8_STAGE(PG8_SA(1, 0), cA + kstep, vA00, vA01); PG8_STAGE_B(PG8_SB(1, 1), cB + hstep + kstep);
    PG8_WAIT_V(6); PG8_BAR;
    for (;;) {
        const bool has_next = S.next(ui + 1, nxt);
        const char* nA = has_next ? nxt.A : cA; const char* nB = has_next ? nxt.B : cB;
        if constexpr (Sched::GATHER) { vN00 = vA00; vN01 = vA01; vN10 = vA10; vN11 = vA11;
            if (has_next) { vN00 = S.a_off(nxt, sR[0], sC[0]); vN01 = S.a_off(nxt, sR[1], sC[1]); vN10 = S.a_off(nxt, HALF + sR[0], sC[0]); vN11 = S.a_off(nxt, HALF + sR[1], sC[1]); } }
        for (int t = 0; t < nt; t += 2) {
            const bool last = (t == nt - 2);
            const char* a1 = cA + (size_t)(t + 1) * kstep;
            const char* a2 = last ? nA : cA + (size_t)(t + 2) * kstep; const char* b2 = last ? nB : cB + (size_t)(t + 2) * kstep;
            const char* a3 = a2 + kstep; const char* b3 = b2 + kstep;
            PG8_LDB(B0, 0, 0); PG8_LDB(B1, 0, 1); PG8_SCHED; PG8_LDA(At, 0, 0); PG8_STAGE(PG8_SA(1, 1), a1 + hA, vA10, vA11);
            if constexpr (Sched::GATHER) { if (last) { vA00 = vN00; vA01 = vN01; vA10 = vN10; vA11 = vN11; } }
            PG8_WAIT_V(8); PG8_WAIT_L(0); PG8_BAR; PG8_MMA(0, 0, At, B0); PG8_MMA(0, 1, At, B1); PG8_BAR; PG8_SCHED;
            PG8_LDA(At, 0, 1); PG8_STAGE_B(PG8_SB(0, 0), b2); PG8_STAGE_B(PG8_SB(0, 1), b2 + hstep); PG8_STAGE(PG8_SA(0, 0), a2, vA00, vA01);
            PG8_WAIT_V(8); PG8_WAIT_L(0); PG8_BAR; PG8_MMA(1, 0, At, B0); PG8_MMA(1, 1, At, B1); PG8_BAR; PG8_SCHED;
            PG8_LDB(B0, 1, 0); PG8_LDB(B1, 1, 1); PG8_SCHED; PG8_LDA(At, 1, 0); PG8_STAGE(PG8_SA(0, 1), a2 + hA, vA10, vA11);
            PG8_WAIT_V(8); PG8_WAIT_L(0); PG8_BAR; PG8_MMA(0, 0, At, B0); PG8_MMA(0, 1, At, B1); PG8_BAR; PG8_SCHED;
            PG8_LDA(At, 1, 1); PG8_STAGE_B(PG8_SB(1, 0), b3); PG8_STAGE_B(PG8_SB(1, 1), b3 + hstep); PG8_STAGE(PG8_SA(1, 0), a3, vA00, vA01);
            PG8_WAIT_V(8); PG8_WAIT_L(0); PG8_BAR; PG8_MMA(1, 0, At, B0); PG8_MMA(1, 1, At, B1); PG8_BAR; PG8_SCHED;
        }
        if (PG8_ALIGN_EPI) { if (wr == 0) PG8_BAR; }
        if constexpr (Epi::FP8) asm volatile("s_nop 15\n\ts_nop 15" ::: "memory");
        const bool reset = E(acc, cur, wr, wc, fr, fq);
        if (!has_next) break;
        if (reset) {
#pragma unroll
            for (int a = 0; a < 2; ++a)
#pragma unroll
                for (int b = 0; b < 2; ++b)
#pragma unroll
                    for (int m = 0; m < 4; ++m)
#pragma unroll
                        for (int n = 0; n < 2; ++n) acc[a][b][m][n] = (f32x4){0.f, 0.f, 0.f, 0.f};
        }
        cur = nxt; cA = nA; cB = nB; ++ui;
        if (PG8_ALIGN_EPI) { if (wr == 1) PG8_BAR; }
    }
    PG8_WAIT_V(0);
    if (!PG8_ALIGN_EPI) { if (wr == 0) PG8_BAR; }
    PG8_BAR;
#undef PG8_SA
#undef PG8_SB
#undef PG8_STAGE
#undef PG8_STAGE_B
#undef PG8_LDA
#undef PG8_LDB
#undef PG8_MMA
#undef PG8_WAIT_V
#undef PG8_WAIT_L
#undef PG8_BAR
#undef PG8_SCHED
}

struct SchedLin {
    static constexpr bool GATHER = false;
    int G, c, nM, nN, nsub; const char* A; const char* B; int lda, K; size_t asub, bsub; int wgm;
    __device__ __forceinline__ size_t a_hstep() const { return (size_t)HALF * lda * 2; }
    __device__ __forceinline__ bool next(int i, GUnit& u) const {
        const int j = i / nsub, nb = i - j * nsub; const int L = j * G + c; const int nwg = nM * nN; if (L >= nwg) return false;
        const int wg = xcd_remap(L, nwg), nig = wgm * nN, gid = wg / nig, fm = gid * wgm, rem = wg - gid * nig, gsz = (nM - fm) < wgm ? (nM - fm) : wgm;
        u.pm = fm + rem % gsz; u.pn = rem / gsz; u.aux = nb; u.rowbase = u.pm * BM;
        u.A = A + (size_t)u.pm * BM * lda * 2 + nb * asub; u.B = B + (size_t)u.pn * BM * K * 2 + nb * bsub; return true;
    }
    __device__ __forceinline__ unsigned a_off(const GUnit&, int row, int col) const { return (unsigned)(row * lda + col) * 2u; }
};
struct SchedGU {
    static constexpr bool GATHER = true;
    int G, c; const char* H; const char* W; const int* idx;
    __device__ __forceinline__ size_t a_hstep() const { return 0; }
    __device__ __forceinline__ bool next(int i, GUnit& u) const {
        const int L = i * G + c; if (L >= 1536) return false;
        const int wg = xcd_remap(L, 1536); int e, pm, pn, lb;
        if (wg < 1024) { e = wg >> 6; const int r = wg & 63; pm = r & 7; pn = r >> 3; lb = 16384 + e * 2048; }
        else { const int w2 = wg - 1024; e = w2 >> 5; const int r = w2 & 31; pm = r & 3; pn = r >> 2; lb = e * 1024; }
        u.pm = pm; u.pn = pn; u.aux = e; u.rowbase = lb + pm * BM; u.A = H; u.B = W + ((size_t)e * 2048 + (size_t)pn * BM) * 1024; return true;
    }
    __device__ __forceinline__ unsigned a_off(const GUnit& u, int row, int col) const { return (unsigned)(idx[u.rowbase + row] * 512 + col) * 2u; }
};
struct SchedDown {
    static constexpr bool GATHER = false;
    int G, c; const char* A; const char* W;
    __device__ __forceinline__ size_t a_hstep() const { return (size_t)HALF * 1024; }
    __device__ __forceinline__ bool next(int i, GUnit& u) const {
        const int L = i * G + c; if (L >= 768) return false;
        const int wg = xcd_remap(L, 768); const int pm = wg >> 2, pn = wg & 3; const int e = pm < 64 ? (pm >> 2) : ((pm - 64) >> 3);
        u.pm = pm; u.pn = pn; u.aux = e; u.rowbase = pm * BM; u.A = A + (size_t)pm * BM * 1024; u.B = W + ((size_t)e * 1024 + (size_t)pn * BM) * 1024; return true;
    }
    __device__ __forceinline__ unsigned a_off(const GUnit&, int row, int col) const { return (unsigned)(row * 512 + col) * 2u; }
};

struct EpiWin {
    static constexpr bool PERM = true, FP8 = false; bf16_t* BIG; float* out; int layer;
    __device__ __forceinline__ bool operator()(f32x4 (&acc)[2][2][4][2], const GUnit& u, int wr, int wc, int fr, int fq) const {
        const int pm = u.pm, pn = u.pn; const float qs = (pn + 1) * BM <= C_NAK ? C2 : 1.0f;
#pragma unroll
        for (int bj = 0; bj < 2; ++bj) {
            const int col = pn * BM + bj * HALF + wc * 32 + 8 * fq;
            float* sp = nullptr; int spitch = 0, scol = 0;
            if (pm < 32) {
                if (col >= C_NAK && col < C_NAV) { sp = out + O_SNAK; spitch = 512; scol = col - C_NAK; }
                else if (col >= C_NAV && col < C_GQ) { sp = out + O_SNAV; spitch = 512; scol = col - C_NAV; }
                else if (col >= C_GV && col < C_CVB) { sp = out + O_SGV; spitch = 128; scol = col - C_GV; }
            }
#pragma unroll
            for (int ai = 0; ai < 2; ++ai)
#pragma unroll
                for (int m = 0; m < 4; ++m) {
                    const int t = ai * HALF + wr * 64 + m * 16 + fr; const size_t row = (size_t)pm * BM + t;
                    const f32x4 v0 = acc[ai][bj][m][0], v1 = acc[ai][bj][m][1]; const f32x4 s0 = v0 * qs, s1 = v1 * qs;
                    u32x4 w; w.x = cvt_pk_bf16(s0[0], s0[1]); w.y = cvt_pk_bf16(s0[2], s0[3]); w.z = cvt_pk_bf16(s1[0], s1[1]); w.w = cvt_pk_bf16(s1[2], s1[3]);
                    *(u32x4*)(BIG + row * INW + col) = w;
                    if (sp) { float* o = sp + ((size_t)(pm * 4 + layer) * 256 + t) * spitch + scol; *(f32x4*)o = v0; *(f32x4*)(o + 4) = v1; }
                }
        }
        return true;
    }
};
struct EpiWinGate {
    static constexpr bool PERM = true, FP8 = true; bf16_t* BIG;
    __device__ __forceinline__ bool operator()(f32x4 (&acc)[2][2][4][2], const GUnit& u, int wr, int wc, int fr, int fq) const {
#pragma unroll
        for (int bj = 0; bj < 2; ++bj) {
            const int col = C_F8 + u.pn * BM + bj * HALF + wc * 32 + 8 * fq; const bool gate = col >= C_GATE;
#pragma unroll
            for (int ai = 0; ai < 2; ++ai)
#pragma unroll
                for (int m = 0; m < 4; ++m) {
                    const size_t row = (size_t)u.pm * BM + ai * HALF + wr * 64 + m * 16 + fr;
                    f32x4 v0 = acc[ai][bj][m][0], v1 = acc[ai][bj][m][1];
                    if (gate) {
#pragma unroll
                        for (int j = 0; j < 4; ++j) { v0[j] = fmaxf(sigmoidf_(v0[j]) * 255.0f, 1.0f); v1[j] = fmaxf(sigmoidf_(v1[j]) * 255.0f, 1.0f); }
                        u32x2 w; w.x = pack4_u8(v0[0], v0[1], v0[2], v0[3]); w.y = pack4_u8(v1[0], v1[1], v1[2], v1[3]);
                        *(u32x2*)((unsigned char*)(BIG + row * INW + C_GATE) + (col - C_GATE)) = w;
                    } else { u32x4 w; w.x = cvt_pk_bf16(v0[0], v0[1]); w.y = cvt_pk_bf16(v0[2], v0[3]); w.z = cvt_pk_bf16(v1[0], v1[1]); w.w = cvt_pk_bf16(v1[2], v1[3]);
                        *(u32x4*)(BIG + row * INW + col) = w; }
                }
        }
        return true;
    }
};
struct EpiBranch {
    static constexpr bool PERM = true, FP8 = true; const bf16_t* BIG; bf16_t* MRG;
    __device__ __forceinline__ bool operator()(f32x4 (&acc)[2][2][4][2], const GUnit& u, int wr, int wc, int fr, int fq) const {
        const int nb = u.aux; const bool last = nb == 3; const int dofs = last ? 0 : 1024;
#pragma unroll
        for (int ai = 0; ai < 2; ++ai) {
            const size_t row0 = (size_t)u.pm * BM + ai * HALF + wr * 64 + fr; const int col0 = u.pn * BM + wc * 32 + 8 * fq;
            const unsigned char* gp = (const unsigned char*)(BIG + row0 * INW + C_GATE) + nb * 1024 + col0;
#pragma unroll
            for (int bj = 0; bj < 2; ++bj) {
                u32x2 g0[4], g1[4];
#pragma unroll
                for (int m = 0; m < 4; ++m) { g0[m] = *(const u32x2*)(gp + (size_t)m * 16 * INW * 2 + bj * HALF); g1[m] = *(const u32x2*)(gp + (size_t)m * 16 * INW * 2 + bj * HALF + dofs); }
#pragma unroll
                for (int m = 0; m < 4; ++m) {
                    float s[8], d[8]; u8x8_to_f32(g0[m], s); u8x8_to_f32(g1[m], d);
#pragma unroll
                    for (int j = 0; j < 8; ++j) s[j] = last ? s[j] * (1.0f / 255.0f) : s[j] * __builtin_amdgcn_rcpf(d[j]);
                    f32x4 v0 = acc[ai][bj][m][0], v1 = acc[ai][bj][m][1];
#pragma unroll
                    for (int j = 0; j < 4; ++j) { v0[j] *= s[j]; v1[j] *= s[4 + j]; }
                    acc[ai][bj][m][0] = v0; acc[ai][bj][m][1] = v1;
                    if (last) { u32x4 w; w.x = cvt_pk_bf16(v0[0], v0[1]); w.y = cvt_pk_bf16(v0[2], v0[3]); w.z = cvt_pk_bf16(v1[0], v1[1]); w.w = cvt_pk_bf16(v1[2], v1[3]);
                        *(u32x4*)(MRG + (row0 + m * 16) * D + col0 + bj * HALF) = w; }
                }
                asm volatile("" ::: "memory");
            }
        }
        return last;
    }
};
struct EpiWout {
    static constexpr bool PERM = true, FP8 = false; const bf16_t* x; const float* mod; bf16_t* V;
    __device__ __forceinline__ bool operator()(f32x4 (&acc)[2][2][4][2], const GUnit& u, int wr, int wc, int fr, int fq) const {
        const int mr = u.pm < 32 ? 0 : 1 + ((u.pm - 32) >> 3); const float* g1 = mod + mr * 6144 + 2048;
#pragma unroll
        for (int bj = 0; bj < 2; ++bj) {
            const int col = u.pn * BM + bj * HALF + wc * 32 + 8 * fq; const f32x4 gv0 = *(const f32x4*)(g1 + col), gv1 = *(const f32x4*)(g1 + col + 4);
            const size_t off0 = ((size_t)u.pm * BM + wr * 64 + fr) * D + col;
#pragma unroll
            for (int ai = 0; ai < 2; ++ai) {
                u32x4 xv[4];
#pragma unroll
                for (int m = 0; m < 4; ++m) xv[m] = *(const u32x4*)(x + off0 + (size_t)(ai * HALF + m * 16) * D);
#pragma unroll
                for (int m = 0; m < 4; ++m) { const u32x4 a = xv[m]; const f32x4 x0 = {h16lo(a.x), h16hi(a.x), h16lo(a.y), h16hi(a.y)}, x1 = {h16lo(a.z), h16hi(a.z), h16lo(a.w), h16hi(a.w)};
                    const f32x4 v0 = ALPHA * x0 + gv0 * acc[ai][bj][m][0], v1 = ALPHA * x1 + gv1 * acc[ai][bj][m][1];
                    u32x4 w; w.x = cvt_pk_f16(v0[0], v0[1]); w.y = cvt_pk_f16(v0[2], v0[3]); w.z = cvt_pk_f16(v1[0], v1[1]); w.w = cvt_pk_f16(v1[2], v1[3]);
                    *(u32x4*)(V + off0 + (size_t)(ai * HALF + m * 16) * D) = w; }
                asm volatile("" ::: "memory");
            }
        }
        return true;
    }
};
struct EpiGU {
    static constexpr bool PERM = true, FP8 = true; unsigned char* HDN8;
    __device__ __forceinline__ bool operator()(f32x4 (&acc)[2][2][4][2], const GUnit& u, int wr, int wc, int fr, int fq) const {
#pragma unroll
        for (int ai = 0; ai < 2; ++ai)
#pragma unroll
            for (int m = 0; m < 4; ++m) { const size_t row = (size_t)u.rowbase + ai * HALF + wr * 64 + m * 16 + fr; float h[8];
#pragma unroll
                for (int n = 0; n < 2; ++n)
#pragma unroll
                    for (int j = 0; j < 4; ++j) { const float g = acc[ai][0][m][n][j], up = acc[ai][1][m][n][j]; h[4 * n + j] = g * sigmoidf_(g) * up; }
                u32x2 w; w.x = cvt4_fp8_sat(h[0], h[1], h[2], h[3]); w.y = cvt4_fp8_sat(h[4], h[5], h[6], h[7]);
                *(u32x2*)(HDN8 + row * 1024 + u.pn * HALF + wc * 32 + 8 * fq) = w; }
        return true;
    }
};
struct EpiDown {
    static constexpr bool PERM = true, FP8 = true; unsigned char* YE8;
    __device__ __forceinline__ bool operator()(f32x4 (&acc)[2][2][4][2], const GUnit& u, int wr, int wc, int fr, int fq) const {
#pragma unroll
        for (int ai = 0; ai < 2; ++ai)
#pragma unroll
            for (int m = 0; m < 4; ++m) { const size_t row = (size_t)u.rowbase + ai * HALF + wr * 64 + m * 16 + fr;
#pragma unroll
                for (int bj = 0; bj < 2; ++bj) { const f32x4 v0 = acc[ai][bj][m][0] * 16.0f, v1 = acc[ai][bj][m][1] * 16.0f;
                    u32x2 w; w.x = cvt4_fp8_sat(v0[0], v0[1], v0[2], v0[3]); w.y = cvt4_fp8_sat(v1[0], v1[1], v1[2], v1[3]);
                    *(u32x2*)(YE8 + row * 1024 + u.pn * BM + bj * HALF + wc * 32 + 8 * fq) = w; } }
        return true;
    }
};
}

struct AUnit { int opitch; const bf16_t* q; unsigned char* o; const bf16_t* k0; const bf16_t* v0; const bf16_t* k1; const bf16_t* v1; int pitch0, pitch1, nt0, nt1, na, qrow0, krow0; const float* rpb; };
constexpr int KP = 72;
constexpr int VPB = 192;
constexpr int ATT_KBUF = 64 * KP * 2, ATT_VBUF = 64 * VPB, ATT_K = 0, ATT_V = 4 * ATT_KBUF, ATT_RPB = ATT_V + 4 * ATT_VBUF;
static_assert(ATT_RPB + 465 * 4 <= RING_BYTES, "attention LDS");
typedef short v4i16_t __attribute__((ext_vector_type(4)));
__device__ __forceinline__ u32x2 vtr(const LAS unsigned char* p) { return __builtin_bit_cast(u32x2, __builtin_amdgcn_ds_read_tr16_b64_v4i16((LAS v4i16_t*)p)); }

struct APre { bf16x8 q[4]; u32x4 kA, vA, kB, vB; float rpb; };
__device__ __forceinline__ void att_tile_ptrs(const AUnit& u, int t, int skey, int sch, const bf16_t*& kp, const bf16_t*& vp) {
    if (t < u.nt0) { const size_t o = (size_t)(t * 64 + skey) * u.pitch0 + sch * 8; kp = u.k0 + o; vp = u.v0 + o; }
    else { const size_t o = (size_t)((t - u.nt0) * 64 + skey) * u.pitch1 + sch * 8; kp = u.k1 + o; vp = u.v1 + o; }
}
__device__ __forceinline__ void att_pre_q(const AUnit& u, int tid, APre& p) {
    const int lane = tid & 63, wid = tid >> 6; const bf16_t* qp = u.q + (size_t)(wid * 32 + (lane & 31)) * INW + (lane >> 5) * 8;
#pragma unroll
    for (int ks = 0; ks < 4; ++ks) p.q[ks] = *(const bf16x8*)(qp + ks * 16);
    p.rpb = (u.na && tid < 465) ? u.rpb[tid] : 0.f;
}
__device__ __forceinline__ void att_pre_t0(const AUnit& u, int tid, APre& p) { const bf16_t *kp, *vp; att_tile_ptrs(u, 0, tid >> 3, tid & 7, kp, vp); p.kA = *(const u32x4*)kp; p.vA = *(const u32x4*)vp; }
__device__ __forceinline__ void att_pre_t1(const AUnit& u, int tid, APre& p) { const bf16_t *kp, *vp; att_tile_ptrs(u, 1, tid >> 3, tid & 7, kp, vp); p.kB = *(const u32x4*)kp; p.vB = *(const u32x4*)vp; }
template <int VAR, bool NA> __device__ __forceinline__ void attn_unit(LAS unsigned char* lds, const AUnit& u, APre& pre, const AUnit& un, const bool has_next) {
    const int tid = opaque_v((int)threadIdx.x), lane = tid & 63, r32 = lane & 31, hh = lane >> 5; const int wid = __builtin_amdgcn_readfirstlane(tid >> 6);
    LAS float* rpbS = (LAS float*)(lds + ATT_RPB);
    bf16x8 qf[4];
#pragma unroll
    for (int ks = 0; ks < 4; ++ks) qf[ks] = pre.q[ks];
    if (NA) { if (tid < 465) rpbS[tid] = pre.rpb * LOG2E; }
    asm volatile("" :: "v"(qf[0]), "v"(qf[1]), "v"(qf[2]), "v"(qf[3]));
    const int skey = tid >> 3, sch = tid & 7, NT = u.nt0 + u.nt1;
    u32x4 kA = pre.kA, vA = pre.vA, kB = pre.kB, vB = pre.vB;
    const bf16_t *uk0 = u.k0, *uv0 = u.v0, *uk1 = u.k1 ? u.k1 : u.k0, *uv1 = u.v1 ? u.v1 : u.v0, *nk0 = un.k0, *nv0 = un.v0, *nk1 = un.k1 ? un.k1 : un.k0, *nv1 = un.v1 ? un.v1 : un.v0;
    int up0 = u.pitch0, up1 = u.pitch1, unt0 = u.nt0, np0 = un.pitch0, np1 = un.pitch1, nnt0 = un.nt0;
    asm volatile("" : "+s"(uk0), "+s"(uv0), "+s"(uk1), "+s"(uv1), "+s"(nk0), "+s"(nv0), "+s"(nk1), "+s"(nv1));
    asm volatile("" : "+s"(up0), "+s"(up1), "+s"(unt0), "+s"(np0), "+s"(np1), "+s"(nnt0));
#define ATT_LOAD(t, KR, VR, TN) do { if (VAR & 4) break; const bool own_ = (t) < NT; const bf16_t *kp_, *vp_; \
        { const int tt_ = own_ ? (t) : (TN); const int nt0_ = own_ ? unt0 : nnt0; const bool c0_ = tt_ < nt0_; const int tr_ = c0_ ? tt_ : tt_ - nt0_; \
          const bf16_t* kb_ = own_ ? (c0_ ? uk0 : uk1) : (c0_ ? nk0 : nk1); const bf16_t* vb_ = own_ ? (c0_ ? uv0 : uv1) : (c0_ ? nv0 : nv1); const int pt_ = own_ ? (c0_ ? up0 : up1) : (c0_ ? np0 : np1); \
          const size_t o_ = (size_t)(tr_ * 64 + skey) * pt_ + sch * 8; kp_ = kb_ + o_; vp_ = vb_ + o_; } \
        KR = *(const u32x4*)kp_; VR = *(const u32x4*)vp_; } while (0)
#define ATT_WRITE(b, KR, VR) do { if (VAR & 4) break; *(LAS u32x4*)(lds + ATT_K + (b) * ATT_KBUF + skey * (KP * 2) + sch * 16) = KR; *(LAS u32x4*)(lds + ATT_V + (b) * ATT_VBUF + skey * VPB + sch * 16) = VR; } while (0)
#define ATT_SYNC() do { asm volatile("s_waitcnt lgkmcnt(0)" ::: "memory"); if (!(VAR & 16)) __builtin_amdgcn_s_barrier(); asm volatile("" ::: "memory"); } while (0)
    ATT_WRITE(0, kA, vA); ATT_WRITE(1, kB, vB);
    ATT_LOAD(2, kA, vA, 0); ATT_LOAD(3, kB, vB, 1);
    ATT_SYNC();
    float mrun = 0.f, lrun = 0.f; f32x16 o0 = {}, o1 = {}, nm16 = {}; bool fresh = true;
    const int qr = u.qrow0 + (wid >> 1), qc = 32 * (wid & 1) + r32;
    const int rs = min(max(qr - 4, 0), 24), cs = min(max(qc - 8, 0), 48);
    const int vtoff = (4 * hh + ((lane & 15) >> 2)) * VPB + (16 * ((lane >> 4) & 1) + 4 * (lane & 3)) * 2;
    bf16x8 kf0[4], kf1[4];
#define ATT_KREAD(t) do { const LAS unsigned char* Kr_ = lds + ATT_K + ((t) & 3) * ATT_KBUF; \
        _Pragma("unroll") for (int ks = 0; ks < 4; ++ks) { kf0[ks] = *(const LAS bf16x8*)(Kr_ + r32 * (KP * 2) + (ks * 16 + hh * 8) * 2); kf1[ks] = *(const LAS bf16x8*)(Kr_ + (32 + r32) * (KP * 2) + (ks * 16 + hh * 8) * 2); } } while (0)
#define ATT_COMPUTE(t, KNEXT) do { \
        const bool local = NA && (t) < u.nt0; const int krow = u.krow0 + (t); \
        const bool active = !local || (krow >= rs && krow < rs + 8); \
        if (active) { \
            const LAS unsigned char* Vb = lds + ATT_V + ((t) & 3) * ATT_VBUF + vtoff; \
            f32x16 p0 = nm16, p1 = nm16; \
            __builtin_amdgcn_sched_barrier(0); \
            _Pragma("unroll") for (int ks = 0; ks < 4; ++ks) { \
                const bf16x8 a0 = kf0[ks], a1 = kf1[ks]; \
                if (VAR & 8) { p0[ks] += __builtin_bit_cast(f32x4, a0)[0]; p1[ks] += __builtin_bit_cast(f32x4, a1)[1]; } else { \
                p0 = __builtin_amdgcn_mfma_f32_32x32x16_bf16(a0, qf[ks], p0, 0, 0, 0); \
                p1 = __builtin_amdgcn_mfma_f32_32x32x16_bf16(a1, qf[ks], p1, 0, 0, 0); } } \
            if (!(VAR & 2)) { float rsum; \
              if (local) { \
                const LAS float* br = rpbS + (krow - qr + 7) * 31 + (15 - qc); \
                float b0[16], b1[16];                            \
                _Pragma("unroll") for (int i = 0; i < 16; ++i) { const int kc = (i & 3) + 8 * (i >> 2) + 4 * hh; b0[i] = br[kc]; b1[i] = br[kc + 32]; } \
                _Pragma("unroll") for (int i = 0; i < 16; ++i) asm volatile("" : "+v"(b0[i]), "+v"(b1[i])); \
                _Pragma("unroll") for (int i = 0; i < 16; ++i) { const int kc = (i & 3) + 8 * (i >> 2) + 4 * hh; \
                    { const bool ok = kc >= cs && kc < cs + 16; p0[i] = ok ? p0[i] + b0[i] : -INFINITY; } \
                    { const int kc1 = kc + 32; const bool ok = kc1 >= cs && kc1 < cs + 16; p1[i] = ok ? p1[i] + b1[i] : -INFINITY; } } } \
              float mt = __builtin_fmaxf(p0[0], p1[0]); \
              _Pragma("unroll") for (int i = 1; i < 16; ++i) mt = __builtin_fmaxf(__builtin_fmaxf(mt, p0[i]), p1[i]); \
              mt = fmaxf(mt, __shfl_xor(mt, 32));                \
              if (fresh || __any(mt > 8.0f)) {                   \
                  const float dl = fresh ? fmaxf(mt, -1e30f) : fmaxf(mt, 0.f), al = fresh ? 1.0f : fast_exp2(-dl); mrun += dl; lrun *= al; fresh = false; \
                  _Pragma("unroll") for (int i = 0; i < 16; ++i) { o0[i] *= al; o1[i] *= al; p0[i] -= dl; p1[i] -= dl; nm16[i] = -mrun; } } \
              _Pragma("unroll") for (int i = 0; i < 16; ++i) { p0[i] = fast_exp2(p0[i]); p1[i] = fast_exp2(p1[i]); } \
              { typedef float f32x2_ __attribute__((ext_vector_type(2))); f32x2_ sa = {p0[0], p0[1]}, sb = {p1[0], p1[1]}; \
                _Pragma("unroll") for (int i = 2; i < 16; i += 2) { sa += (f32x2_){p0[i], p0[i + 1]}; sb += (f32x2_){p1[i], p1[i + 1]}; } \
                sa += sb; rsum = sa[0] + sa[1]; } \
              lrun += rsum; } \
            bf16x8 pf[4]; \
            _Pragma("unroll") for (int s = 0; s < 2; ++s) { \
                u32x4 w; w.x = cvt_pk_bf16(p0[8 * s + 0], p0[8 * s + 1]); w.y = cvt_pk_bf16(p0[8 * s + 2], p0[8 * s + 3]); w.z = cvt_pk_bf16(p0[8 * s + 4], p0[8 * s + 5]); w.w = cvt_pk_bf16(p0[8 * s + 6], p0[8 * s + 7]); \
                pf[s] = __builtin_bit_cast(bf16x8, w); \
                u32x4 x; x.x = cvt_pk_bf16(p1[8 * s + 0], p1[8 * s + 1]); x.y = cvt_pk_bf16(p1[8 * s + 2], p1[8 * s + 3]); x.z = cvt_pk_bf16(p1[8 * s + 4], p1[8 * s + 5]); x.w = cvt_pk_bf16(p1[8 * s + 6], p1[8 * s + 7]); \
                pf[2 + s] = __builtin_bit_cast(bf16x8, x); } \
            __builtin_amdgcn_sched_barrier(0); \
            if ((KNEXT) >= 0) ATT_KREAD(KNEXT); \
            _Pragma("unroll") for (int s = 0; s < 4; ++s) { \
                const LAS unsigned char* vp = Vb + 16 * s * VPB; \
                { const u32x2 lo = vtr(vp), hi = vtr(vp + 8 * VPB); const u32x4 w = {lo.x, lo.y, hi.x, hi.y}; \
                  if (VAR & 8) o0[s] += __builtin_bit_cast(f32x4, w)[0] * __builtin_bit_cast(f32x4, pf[s])[1]; else o0 = __builtin_amdgcn_mfma_f32_32x32x16_bf16(__builtin_bit_cast(bf16x8, w), pf[s], o0, 0, 0, 0); } \
                { const u32x2 lo = vtr(vp + 64), hi = vtr(vp + 8 * VPB + 64); const u32x4 w = {lo.x, lo.y, hi.x, hi.y}; \
                  if (VAR & 8) o1[s] += __builtin_bit_cast(f32x4, w)[2] * __builtin_bit_cast(f32x4, pf[s])[3]; else o1 = __builtin_amdgcn_mfma_f32_32x32x16_bf16(__builtin_bit_cast(bf16x8, w), pf[s], o1, 0, 0, 0); } } \
        } else if ((KNEXT) >= 0) ATT_KREAD(KNEXT); } while (0)
    for (int t = 0; t < NT; t += 2) {
        ATT_KREAD(t);
        ATT_COMPUTE(t, (t + 1 < NT ? t + 1 : -1));
        if (t + 1 < NT) ATT_COMPUTE(t + 1, -1);
        ATT_WRITE((t + 2) & 3, kA, vA); ATT_WRITE((t + 3) & 3, kB, vB);
        ATT_LOAD(t + 4, kA, vA, 0); ATT_LOAD(t + 5, kB, vB, 1);
        ATT_SYNC();
    }
    pre.kA = kA; pre.vA = vA; pre.kB = kB; pre.vB = vB;
    att_pre_q(un, tid, pre);
    const float ltot = lrun + __shfl_xor(lrun, 32), inv = 1.0f / ltot;
    unsigned char* op = u.o + (size_t)(wid * 32 + r32) * u.opitch + 16 * hh;
    { unsigned w0[4], w1[4];
#pragma unroll
      for (int g = 0; g < 4; ++g) { w0[g] = cvt4_fp8(o0[4 * g] * inv, o0[4 * g + 1] * inv, o0[4 * g + 2] * inv, o0[4 * g + 3] * inv); w1[g] = cvt4_fp8(o1[4 * g] * inv, o1[4 * g + 1] * inv, o1[4 * g + 2] * inv, o1[4 * g + 3] * inv); }
      const unsigned ra0 = (unsigned)__shfl_xor((int)(hh ? w0[0] : w0[2]), 32), rb0 = (unsigned)__shfl_xor((int)(hh ? w0[1] : w0[3]), 32);
      const unsigned ra1 = (unsigned)__shfl_xor((int)(hh ? w1[0] : w1[2]), 32), rb1 = (unsigned)__shfl_xor((int)(hh ? w1[1] : w1[3]), 32);
      const u32x4 s0 = hh ? (u32x4){ra0, w0[2], rb0, w0[3]} : (u32x4){w0[0], ra0, w0[1], rb0};
      const u32x4 s1 = hh ? (u32x4){ra1, w1[2], rb1, w1[3]} : (u32x4){w1[0], ra1, w1[1], rb1};
      *(u32x4*)op = s0; *(u32x4*)(op + 32) = s1; }
#undef ATT_LOAD
#undef ATT_WRITE
#undef ATT_SYNC
#undef ATT_COMPUTE
#undef ATT_KREAD
}

__device__ __forceinline__ void att_make_unit(const Args& a, int l, int au, const bf16_t* BIG, unsigned char* BR, int BRW_, AUnit& u) {
        u.k1 = nullptr; u.v1 = nullptr; u.pitch1 = 0; u.nt1 = 0; u.na = 0; u.qrow0 = 0; u.krow0 = 0; u.rpb = nullptr; u.pitch0 = INW;
        if (au < 512) {
            const int b = au >> 6, h = (au >> 3) & 7, qb = au & 7; const size_t rq = (size_t)NCTX + b * 2048 + qb * 256, rk = (size_t)NCTX + b * 2048;
            u.q = BIG + rq * INW + C_GQ + h * 64; u.o = BR + rq * BRW_ + 512 + h * 64;
            u.k0 = BIG + rk * INW + C_GK + (h >> 2) * 64; u.v0 = BIG + rk * INW + C_GV + (h >> 2) * 64; u.nt0 = 32;
            const size_t co = (size_t)((b * 4 + l) * 512) * 128 + (h >> 2) * 64;
            u.k1 = (const bf16_t*)(a.ws + WS_CGK) + co; u.v1 = (const bf16_t*)(a.ws + WS_CGV) + co; u.pitch1 = 128; u.nt1 = 8;
        } else if (au < 1024) {
            const int a2 = au - 512, b = a2 >> 6, h = (a2 >> 3) & 7, rq4 = a2 & 7; const size_t rq = (size_t)NCTX + b * 2048 + rq4 * 256;
            u.q = BIG + rq * INW + C_NAQ + h * 64; u.o = BR + rq * BRW_ + h * 64;
            u.qrow0 = 4 * rq4; u.krow0 = min(max(4 * rq4 - 4, 0), 24); const int kend = min(max(4 * rq4 - 1, 0), 24) + 8; u.nt0 = kend - u.krow0;
            const size_t rk = (size_t)NCTX + b * 2048 + u.krow0 * 64;
            u.k0 = BIG + rk * INW + C_NAK + h * 64; u.v0 = BIG + rk * INW + C_NAV + h * 64;
            const size_t co = (size_t)((b * 4 + l) * 512) * 512 + h * 64;
            u.k1 = (const bf16_t*)(a.ws + WS_CNAK) + co; u.v1 = (const bf16_t*)(a.ws + WS_CNAV) + co; u.pitch1 = 512; u.nt1 = 8;
            u.na = 1; u.rpb = a.in[I_RPB] + (size_t)(l * 8 + h) * 465;
        } else {
            const int a3 = au - 1024, kind = a3 >> 8, b = (a3 & 255) >> 3, h = a3 & 7; const size_t rq = (size_t)b * 256;
            if (kind == 0) { u.q = BIG + rq * INW + C_NAQ + h * 64; u.k0 = BIG + rq * INW + C_NAK + h * 64; u.v0 = BIG + rq * INW + C_NAV + h * 64; u.o = BR + rq * BRW_ + h * 64; }
            else { u.q = BIG + rq * INW + C_GQ + h * 64; u.k0 = BIG + rq * INW + C_GK + (h >> 2) * 64; u.v0 = BIG + rq * INW + C_GV + (h >> 2) * 64; u.o = BR + rq * BRW_ + 512 + h * 64; }
            u.nt0 = 4;
        }
        u.opitch = BRW_;
}
template <int VAR> __device__ __forceinline__ void ph_attention(const Args& a, int l, LAS unsigned char* lds, int G, int bx) {
    const bf16_t* BIG = (const bf16_t*)(a.ws + WS_BIG); unsigned char* BR = VAR ? a.ws + WS_H : a.ws + WS_BR; const int BRW_ = VAR ? 1024 : BRW;
    if (bx >= 1536) return;
    const int tid0 = opaque_v((int)threadIdx.x);
#define ATT_UMAP(L_) (((L_) & ~511) | ((((L_) & 511) & 7) << 6) | (((L_) & 511) >> 3))
    AUnit u, un; APre pre; att_make_unit(a, l, (G == 256 ? ATT_UMAP(bx) : bx), BIG, BR, BRW_, u);
    att_pre_q(u, tid0, pre); att_pre_t0(u, tid0, pre); att_pre_t1(u, tid0, pre);
    for (int i = 0;; ++i) {
        const int aun = (i + 1) * G + bx; const bool has_next = aun < 1536;
        att_make_unit(a, l, has_next ? (G == 256 ? ATT_UMAP(aun) : aun) : 0, BIG, BR, BRW_, un);
        if (u.na) attn_unit<VAR, true>(lds, u, pre, un, has_next); else attn_unit<VAR, false>(lds, u, pre, un, has_next);
        if (!has_next) break;
        u = un;
    }
}

struct TDesc { const float* sp; unsigned char* wt; int N, K, k0, n0, mode, fp8; };
__device__ __forceinline__ void t_load(const TDesc& d, int lane, f32x4 (&w)[8]) {
    const float* p = d.sp + (size_t)(lane >> 3) * d.N + 4 * (lane & 7);
#pragma unroll
    for (int j = 0; j < 8; ++j) w[j] = __builtin_nontemporal_load((const f32x4*)(p + (size_t)(8 * j) * d.N));
}
__device__ __forceinline__ void t_lds_write(LAS float* scr, int lane, const f32x4 (&w)[8]) {
    LAS float* q = scr + (lane >> 3) * 33 + 4 * (lane & 7);
#pragma unroll
    for (int j = 0; j < 8; ++j) { q[j * 264] = w[j][0]; q[j * 264 + 1] = w[j][1]; q[j * 264 + 2] = w[j][2]; q[j * 264 + 3] = w[j][3]; }
}
__device__ __forceinline__ void t_finish(const TDesc& d, const LAS float* scr, int lane) {
    const int c = lane & 7;
#pragma unroll
    for (int j = 0; j < 4; ++j) { const int n = (lane >> 3) + 8 * j, nn = d.n0 + n; const int orow = d.mode == 0 ? nn : (((nn >> 7) << 8) + (nn & 127) + (d.mode == 2 ? 128 : 0));
        const LAS float* s = scr + (8 * c) * 33 + n;
        if (d.fp8) { u32x2 o; o.x = cvt4_fp8_sat(s[0 * 33] * W8_SCALE, s[1 * 33] * W8_SCALE, s[2 * 33] * W8_SCALE, s[3 * 33] * W8_SCALE); o.y = cvt4_fp8_sat(s[4 * 33] * W8_SCALE, s[5 * 33] * W8_SCALE, s[6 * 33] * W8_SCALE, s[7 * 33] * W8_SCALE);
            __builtin_nontemporal_store(o, (u32x2*)(d.wt + (size_t)orow * d.K + d.k0 + 8 * c)); }
        else { u32x4 o; o.x = cvt_pk_bf16(s[0 * 33], s[1 * 33]); o.y = cvt_pk_bf16(s[2 * 33], s[3 * 33]); o.z = cvt_pk_bf16(s[4 * 33], s[5 * 33]); o.w = cvt_pk_bf16(s[6 * 33], s[7 * 33]);
            __builtin_nontemporal_store(o, (u32x4*)((bf16_t*)d.wt + (size_t)orow * d.K + d.k0 + 8 * c)); } }
}
constexpr int NI_WINB = 16 * (C_F8 / 32), NI_WIN8 = 16 * (NF8 / 32), NI_WIN = NI_WINB + NI_WIN8, NI_BR = 3 * 256, NI_WO = 512, NI_E = 16 * 512, LAYER_ITEMS = NI_WIN + NI_BR + NI_WO + 3 * NI_E;
constexpr int NT_ITEMS = DEPTH * LAYER_ITEMS, NF_ITEMS = 1024, NC_ITEMS = 40960, P0_ITEMS = NT_ITEMS + NF_ITEMS + NC_ITEMS;
__device__ __forceinline__ TDesc tdesc(const Args& a, int it) {
    const int l = it / LAYER_ITEMS; int r = it - l * LAYER_ITEMS; const float* W; unsigned char* wt; int K = 1024, N = 1024, ncols = 1024, mode = 0, fp8 = 1;
    if (r < NI_WINB) { W = a.in[I_WIN] + (size_t)l * 1024 * INW; N = INW; ncols = C_F8; wt = a.ws + WS_WI + (size_t)l * INW * 1024 * 2; fp8 = 0; }
    else if ((r -= NI_WINB) < NI_WIN8) { W = a.in[I_WIN] + (size_t)l * 1024 * INW + C_F8; N = INW; ncols = NF8; wt = a.ws + WS_WI8 + (size_t)l * NF8 * 1024; }
    else if ((r -= NI_WIN8) < NI_BR) { const int n = r >> 8; r &= 255; W = a.in[I_WBR] + (size_t)(l * 4 + n) * 512 * 1024; K = 512; wt = a.ws + WS_WBR + (size_t)(l * 4 + n) * 1024 * 512; }
    else if ((r -= NI_BR) < NI_WO) { W = a.in[I_WOUT] + (size_t)l * 1024 * 1024; wt = a.ws + WS_WO + (size_t)l * 1024 * 1024 * 2; fp8 = 0; }
    else { r -= NI_WO; const int which = r / NI_E; r -= which * NI_E; const int e = r >> 9; r &= 511; const size_t le = (size_t)(l * 16 + e);
        if (which == 0) { W = a.in[I_WG] + le * 1048576; wt = a.ws + WS_WGU8 + le * 2097152; mode = 1; }
        else if (which == 1) { W = a.in[I_WU] + le * 1048576; wt = a.ws + WS_WGU8 + le * 2097152; mode = 2; }
        else { W = a.in[I_WDN] + le * 1048576; wt = a.ws + WS_WD8 + le * 1048576; } }
    const int nblk = ncols >> 5, kb = r / nblk, nb = r - kb * nblk;
    TDesc d; d.sp = W + (size_t)(kb << 6) * N + (nb << 5); d.wt = wt; d.N = N; d.K = K; d.k0 = kb << 6; d.n0 = nb << 5; d.mode = mode; d.fp8 = fp8; return d;
}
constexpr int EARLY = NI_WIN + NI_BR + NI_WO;
#ifndef SLICE_A
#define SLICE_A 8000
#define SLICE_B 11500
#define SLICE_C 6000
#endif
constexpr int OFF_A = 0, OFF_B = SLICE_A, OFF_C = SLICE_A + SLICE_B, OFF_T = SLICE_A + SLICE_B + SLICE_C, SLICE_T = LAYER_ITEMS - OFF_T;
static_assert(SLICE_T >= 0 && SLICE_T <= 10000, "slices");
__device__ __forceinline__ void conv_loop(const Args& a, LAS float* scr, int lane, int j0, int jstep, int count, int base) {
    int j = j0; TDesc d{}; f32x4 w[8];
    if (j < count) { d = tdesc(a, base + j); t_load(d, lane, w); }
    while (j < count) {
        t_lds_write(scr, lane, w);
        const int jn = j + jstep; TDesc dn = d;
        if (jn < count) { dn = tdesc(a, base + jn); t_load(dn, lane, w); }
        LDS_WAIT();
        t_finish(d, scr, lane);
        LDS_WAIT();
        d = dn; j = jn; }
}

constexpr int CACHE_ITEMS = 10240;
__device__ __forceinline__ void cache_conv(const Args& a, int lane, int j0, int jstep, int L) {
    for (int it = j0; it < CACHE_ITEMS; it += 5 * jstep) { f32x4 x0[5], x1[5]; bf16_t* dp[5];
#pragma unroll
        for (int u = 0; u < 5; ++u) { int j = min(it + u * jstep, CACHE_ITEMS - 1); const float* src; bf16_t* dst; size_t r;
            if (j < 4096) { src = a.in[I_CNAK]; dst = (bf16_t*)(a.ws + WS_CNAK); r = (size_t)((j >> 9) * 4 + L) * 512 + (j & 511); }
            else if (j < 8192) { j -= 4096; src = a.in[I_CNAV]; dst = (bf16_t*)(a.ws + WS_CNAV); r = (size_t)((j >> 9) * 4 + L) * 512 + (j & 511); }
            else if (j < 9216) { j -= 8192; src = a.in[I_CGK]; dst = (bf16_t*)(a.ws + WS_CGK); r = (size_t)((j >> 7) * 4 + L) * 128 + (j & 127); }
            else { j -= 9216; src = a.in[I_CGV]; dst = (bf16_t*)(a.ws + WS_CGV); r = (size_t)((j >> 7) * 4 + L) * 128 + (j & 127); }
            const size_t e0 = r * 512 + lane * 8; x0[u] = *(const f32x4*)(src + e0); x1[u] = *(const f32x4*)(src + e0 + 4); dp[u] = dst + e0; }
#pragma unroll
        for (int u = 0; u < 5; ++u) { u32x4 w; w.x = cvt_pk_bf16(x0[u][0], x0[u][1]); w.y = cvt_pk_bf16(x0[u][2], x0[u][3]); w.z = cvt_pk_bf16(x1[u][0], x1[u][1]); w.w = cvt_pk_bf16(x1[u][2], x1[u][3]);
            *(u32x4*)dp[u] = w; } }
}
__device__ __forceinline__ void ph_prologue(const Args& a, LAS unsigned char* lds, int G, int bx, int tid, int wave, int lane) {
    { const int gt = bx * 512 + tid;
      if (gt < 1024) { const int pos = gt >> 4, f = gt & 15; const double invd = exp10(-(double)f * 0.25);
          const float ang = (float)pos * (float)invd; const double x = (double)ang;
          const double k = rint(x * 0.15915494309189535); const double r = fma(-k, 6.283185307179586, x) - k * 2.4492935982947064e-16;
          const double r2 = r * r; double ts = r, ss = r, tc = 1.0, sc = 1.0;
          for (int q = 1; q <= 14; ++q) { ts *= -r2 / (double)((2 * q) * (2 * q + 1)); ss += ts; tc *= -r2 / (double)((2 * q - 1) * (2 * q)); sc += tc; }
          float* rt = (float*)(a.ws + WS_ROPE); rt[2 * gt] = (float)sc; rt[2 * gt + 1] = (float)ss; ((unsigned*)(a.ws + WS_ROPE + 8192))[gt] = cvt_pk_f16((float)sc, (float)ss); } }
    if (bx < 384) {
        LAS float* sil = (LAS float*)lds; LAS float* part = (LAS float*)(lds + 36864);
        for (int i = tid; i < 9 * 1024; i += 512) { const int r = i >> 10, d = i & 1023; const float cv = r == 0 ? a.in[I_CCTX][d] : a.in[I_C][(r - 1) * 1024 + d]; sil[i] = cv * sigmoidf_(cv); }
        __syncthreads();
        for (int it = bx; it < 384; it += G) { const int l = it / 96, cg = it - l * 96;
            float acc[9];
#pragma unroll
            for (int r = 0; r < 9; ++r) acc[r] = 0.f;
            const float* wp = a.in[I_WADA] + ((size_t)l * 1024 + wave * 128) * 6144 + cg * 64 + lane;
#pragma unroll 32
            for (int d = 0; d < 128; ++d) { const float wv = wp[(size_t)d * 6144];
#pragma unroll
                for (int r = 0; r < 9; ++r) acc[r] += sil[r * 1024 + wave * 128 + d] * wv; }
#pragma unroll
            for (int r = 0; r < 9; ++r) part[(wave * 9 + r) * 64 + lane] = acc[r];
            __syncthreads();
            for (int i = tid; i < 576; i += 512) { const int r = i >> 6, col = i & 63; float s = a.in[I_BADA][l * 6144 + cg * 64 + col];
#pragma unroll
                for (int w = 0; w < 8; ++w) s += part[(w * 9 + r) * 64 + col];
                ((float*)(a.ws + WS_MOD))[(size_t)(l * 9 + r) * 6144 + cg * 64 + col] = s; }
            __syncthreads();
        }
    }
    __syncthreads();
    LAS float* scr = (LAS float*)(lds + wave * 16384);
    const int gw = bx * 8 + wave, NGW = G * 8;
    conv_loop(a, scr, lane, gw, NGW, EARLY, 0);
    for (int r = gw; r < NF_ITEMS; r += NGW) {
            const int l = r >> 8, g = (r >> 6) & 3, cb = (r >> 4) & 3, db = r & 15, c0 = cb * 32, d0 = db * 64;
            const float* pw = a.in[I_POOLW] + ((size_t)(l * 4 + g) * 128 + c0) * 128;
#pragma unroll 16
            for (int q = 0; q < 64; ++q) scr[lane + 64 * q] = pw[lane + 64 * q];
            LDS_WAIT();
            float acc[32];
#pragma unroll
            for (int ci = 0; ci < 32; ++ci) acc[ci] = 0.f;
            const float* wb = a.in[I_WBR] + ((size_t)(l * 4 + 3) * 512 + g * 128) * 1024 + d0 + lane; const float* ps = a.in[I_POOLS] + l * 512 + g * 128;
#pragma unroll 4
            for (int j = 0; j < 128; j += 4) { float wv[4];
#pragma unroll
                for (int q = 0; q < 4; ++q) wv[q] = wb[(size_t)(j + q) * 1024] * ps[j + q];
#pragma unroll
                for (int ci = 0; ci < 32; ++ci) { const f32x4 s4 = *(const LAS f32x4*)(scr + ci * 128 + j); acc[ci] += (s4[0] * wv[0] + s4[1] * wv[1]) + (s4[2] * wv[2] + s4[3] * wv[3]); } }
            unsigned char* o = a.ws + WS_WBR + ((size_t)(l * 4 + 3) * 1024 + d0 + lane) * 512 + g * 128 + c0;
#pragma unroll
            for (int q = 0; q < 4; ++q) { u32x2 w; w.x = cvt4_fp8_sat(acc[8 * q] * W8_SCALE, acc[8 * q + 1] * W8_SCALE, acc[8 * q + 2] * W8_SCALE, acc[8 * q + 3] * W8_SCALE); w.y = cvt4_fp8_sat(acc[8 * q + 4] * W8_SCALE, acc[8 * q + 5] * W8_SCALE, acc[8 * q + 6] * W8_SCALE, acc[8 * q + 7] * W8_SCALE);
                *(u32x2*)(o + 8 * q) = w; }
            LDS_WAIT();
    }
    { const int cb = G > 128 ? 128 : 0;
      if (bx >= cb) cache_conv(a, lane, (bx - cb) * 8 + wave, (G - cb) * 8, 0); }
}

__device__ __forceinline__ float sum16(float v) { v += __shfl_xor(v, 1); v += __shfl_xor(v, 2); v += __shfl_xor(v, 4); v += __shfl_xor(v, 8); return v; }
__device__ __forceinline__ float sum32(float v) { v = sum16(v); v += __shfl_xor(v, 16); return v; }
__device__ __forceinline__ void ph_x(const Args& a, int l, LAS unsigned char* lds, int tid, int gw, int NGW, int lane) {
    const float* mod = (const float*)(a.ws + WS_MOD); bf16_t* H = (bf16_t*)(a.ws + WS_H);
    const int* slot = (const int*)(a.ws + WS_SLOT); const float* aff = (const float*)(a.ws + WS_AFF); const unsigned char* YE = a.ws + WS_YE;
    LAS f32x4* V4 = (LAS f32x4*)lds;
    { f32x4 fv[16];
#pragma unroll
      for (int k = 0; k < 16; ++k) { const int vec = 2 * k + (tid >> 8), u = tid & 255, mr = min((vec - 2) / 3, 8), w = (vec - 2) - 3 * ((vec - 2) / 3);
          const float* src = vec >= 29 ? (l > 0 ? (vec == 29 ? a.in[I_LN1G] : a.in[I_LN1B]) + (l - 1) * 1024 : mod) : vec < 2 ? (l > 0 ? (vec == 0 ? a.in[I_LN2G] : a.in[I_LN2B]) + (l - 1) * 1024 : mod)
                                     : (w == 0 ? (l > 0 ? mod + (size_t)((l - 1) * 9 + mr) * 6144 + 5 * 1024 : mod) : (l < DEPTH ? mod + (size_t)(l * 9 + mr) * 6144 + (w - 1) * 1024 : mod));
          fv[k] = *(const f32x4*)(src + 4 * u); }
#pragma unroll
      for (int k = 0; k < 16; ++k) { const int vec = 2 * k + (tid >> 8), u = tid & 255; V4[vec * 256 + ((u >> 6) * 2 + (u & 1)) * 32 + ((u & 63) >> 1)] = fv[k]; } }
    __syncthreads();
    const int s = lane & 31, r = lane >> 5;
#define XV(vec, c, h) V4[(vec) * 256 + (2 * (c) + (h)) * 32 + s]
    u32x4 xw[4]; int sl = -1; float af = 0.f; f32x2_t st = {0.f, 1.f};
    { const int tok = gw * 2 + r;
      if (l > 0 && gw * 2 < NTOK) { const bf16_t* xb = (const bf16_t*)(a.ws + WS_V) + (size_t)tok * D + 8 * s; st = *(const f32x2_t*)(a.ws + WS_STATS + (size_t)tok * 8);
#pragma unroll
          for (int c = 0; c < 4; ++c) xw[c] = *(const u32x4*)(xb + 256 * c);
          if (s < 16) { sl = slot[(size_t)s * NTOK + tok]; af = aff[tok * 16 + s]; } } }
    for (int t0 = gw * 2; t0 < NTOK; t0 += NGW * 2) {
        const int tok = t0 + r, mr = modrow_of_tok(tok); float* xo = a.out + (size_t)tok * D + 8 * s; bf16_t* xb = (bf16_t*)(a.ws + WS_XB) + (size_t)tok * D + 8 * s; f32x4 x[8];
        if (l == 0) { const float* xi = (tok < NCTX ? a.in[I_XP] + (size_t)tok * D : a.in[I_XS] + (size_t)(tok - NCTX) * D) + 8 * s;
#pragma unroll
            for (int c = 0; c < 4; ++c) { x[2 * c] = *(const f32x4*)(xi + 256 * c); x[2 * c + 1] = *(const f32x4*)(xi + 256 * c + 4); }
        } else {
            const u32x4 xc[4] = {xw[0], xw[1], xw[2], xw[3]}; const int slc = sl; const float afc = af; const f32x2_t stc = st;
            { const int tn = t0 + NGW * 2;
              if (tn < NTOK) { const int tk = tn + r; const bf16_t* xn = (const bf16_t*)(a.ws + WS_V) + (size_t)tk * D + 8 * s; st = *(const f32x2_t*)(a.ws + WS_STATS + (size_t)tk * 8);
#pragma unroll
                  for (int c = 0; c < 4; ++c) xw[c] = *(const u32x4*)(xn + 256 * c);
                  if (s < 16) { sl = slot[(size_t)s * NTOK + tk]; af = aff[tk * 16 + s]; } } }
            f32x4 acc[8];
#pragma unroll
            for (int j = 0; j < 8; ++j) acc[j] = (f32x4){0.f, 0.f, 0.f, 0.f};
            unsigned m = (unsigned)(__ballot(slc >= 0) >> (32 * r)) & 0xffffu;
            const int ebase = tok < NCTX ? 0 : 16384, ecap = tok < NCTX ? 1024 : 2048;
            while (__any(m != 0u)) {
                u32x2 yw[4][4]; float g[4];
#pragma unroll
                for (int j = 0; j < 4; ++j) { const bool valid = m != 0u; const int e = valid ? __builtin_ctz(m) : 0; m &= m - 1u;
                    const int si = __shfl(slc, (lane & 32) + e); g[j] = valid ? __shfl(afc, (lane & 32) + e) * (1.0f / 16.0f) : 0.f;
                    const unsigned char* yr = YE + (size_t)(ebase + e * ecap + (valid ? si : 0)) * D + 8 * s;
#pragma unroll
                    for (int c = 0; c < 4; ++c) yw[j][c] = *(const u32x2*)(yr + 256 * c); }
#pragma unroll
                for (int j = 0; j < 4; ++j)
#pragma unroll
                    for (int c = 0; c < 4; ++c) { float y8[8]; fp8x8_to_f32(yw[j][c], y8);
                        acc[2 * c][0] += g[j] * y8[0]; acc[2 * c][1] += g[j] * y8[1]; acc[2 * c][2] += g[j] * y8[2]; acc[2 * c][3] += g[j] * y8[3];
                        acc[2 * c + 1][0] += g[j] * y8[4]; acc[2 * c + 1][1] += g[j] * y8[5]; acc[2 * c + 1][2] += g[j] * y8[6]; acc[2 * c + 1][3] += g[j] * y8[7]; }
            }
            float s1 = 0.f; asm volatile("" ::: "memory");
#pragma unroll
            for (int c = 0; c < 4; ++c) { const u32x4 w = xc[c];
                x[2 * c] = ((f32x4){h16lo(w.x), h16hi(w.x), h16lo(w.y), h16hi(w.y)} - stc[0]) * stc[1] * XV(29, c, 0) + XV(30, c, 0);
                x[2 * c + 1] = ((f32x4){h16lo(w.z), h16hi(w.z), h16lo(w.w), h16hi(w.w)} - stc[0]) * stc[1] * XV(29, c, 1) + XV(30, c, 1); }
#pragma unroll
            for (int c = 0; c < 4; ++c)
#pragma unroll
                for (int h = 0; h < 2; ++h) { const int j = 2 * c + h; const f32x4 g2 = XV(2 + 3 * mr, c, h); x[j] = ALPHA * x[j] + g2 * acc[j]; s1 += (x[j][0] + x[j][1]) + (x[j][2] + x[j][3]); }
            const float mean = sum32(s1) * (1.f / D); float s2 = 0.f;
#pragma unroll
            for (int j = 0; j < 8; ++j) { x[j] = x[j] - mean; s2 += (x[j][0] * x[j][0] + x[j][1] * x[j][1]) + (x[j][2] * x[j][2] + x[j][3] * x[j][3]); }
            const float rstd = 1.0f / sqrtf(sum32(s2) * (1.f / D) + 1e-6f); asm volatile("" ::: "memory");
#pragma unroll
            for (int c = 0; c < 4; ++c)
#pragma unroll
                for (int h = 0; h < 2; ++h) { const int j = 2 * c + h; x[j] = x[j] * rstd * XV(0, c, h) + XV(1, c, h); }
        }
        if (l == DEPTH) {
#pragma unroll
            for (int c = 0; c < 4; ++c) { *(f32x4*)(xo + 256 * c) = x[2 * c]; *(f32x4*)(xo + 256 * c + 4) = x[2 * c + 1]; } }
        else {
#pragma unroll
            for (int c = 0; c < 4; ++c) { u32x4 w; w.x = cvt_pk_f16(x[2 * c][0], x[2 * c][1]); w.y = cvt_pk_f16(x[2 * c][2], x[2 * c][3]); w.z = cvt_pk_f16(x[2 * c + 1][0], x[2 * c + 1][1]); w.w = cvt_pk_f16(x[2 * c + 1][2], x[2 * c + 1][3]); *(u32x4*)(xb + 256 * c) = w; } }
        if (l < DEPTH) { bf16_t* ho = H + (size_t)tok * D + 8 * s; unsigned char* ho8 = a.ws + WS_H8 + (size_t)tok * D + 8 * s;
#pragma unroll
            for (int c = 0; c < 4; ++c) { asm volatile("" ::: "memory"); const f32x4 h0 = x[2 * c] * (1.0f + XV(4 + 3 * mr, c, 0)) + XV(3 + 3 * mr, c, 0), h1 = x[2 * c + 1] * (1.0f + XV(4 + 3 * mr, c, 1)) + XV(3 + 3 * mr, c, 1);
                u32x4 w; w.x = cvt_pk_bf16(h0[0], h0[1]); w.y = cvt_pk_bf16(h0[2], h0[3]); w.z = cvt_pk_bf16(h1[0], h1[1]); w.w = cvt_pk_bf16(h1[2], h1[3]); *(u32x4*)(ho + 256 * c) = w;
                u32x2 w8; w8.x = cvt4_fp8_sat(h0[0], h0[1], h0[2], h0[3]); w8.y = cvt4_fp8_sat(h1[0], h1[1], h1[2], h1[3]); *(u32x2*)(ho8 + 256 * c) = w8; } }
    }
#undef XV
}

__device__ __forceinline__ void bf8_unpack(u32x4 w, float (&v)[8]) { v[0] = bflo(w.x); v[1] = bfhi(w.x); v[2] = bflo(w.y); v[3] = bfhi(w.y); v[4] = bflo(w.z); v[5] = bfhi(w.z); v[6] = bflo(w.w); v[7] = bfhi(w.w); }
__device__ __forceinline__ void ph_thin(const Args& a, int l, int gw, int NGW, int lane) {
    bf16_t* BIG = (bf16_t*)(a.ws + WS_BIG); unsigned char* BR = a.ws + WS_BR; const unsigned* rope = (const unsigned*)(a.ws + WS_ROPE + 8192);
    const int sub = lane & 7, quarter = sub >> 1, c0 = 8 * lane, half0 = 1 << (lane >> 4), lk = lane & 15; const bf16_t* zrow = (const bf16_t*)(a.ws + WS_ZERO) + c0; const char* zb = (const char*)(a.ws + WS_ZERO);
    for (int q = gw; q < NTOK / 4; q += NGW) {
        const int tok0 = 4 * q; const bool lat = tok0 >= NCTX; const int t0 = lat ? ((tok0 - NCTX) & 2047) : (tok0 & 255), L = lat ? 2048 : 256;
        bf16_t* row0 = BIG + (size_t)tok0 * INW; const int half = opaque_v(half0);
        const unsigned ob = (unsigned)(WS_BIG - WS_ZERO) + (unsigned)(tok0 - half) * (unsigned)(INW * 2) + (unsigned)((C_PLU + c0) * 2), zo = 2u * c0;
#define POOL_LD(idx, ok) (*(const u32x4*)(zb + ((ok) ? ob + (unsigned)(idx) * (unsigned)(INW * 2) : zo)))
        u32x4 wq[4], wk[4], rp[4][2];
#pragma unroll
        for (int k = 0; k < 4; ++k) { wq[k] = *(const u32x4*)(row0 + (size_t)k * INW + C_GQ + 8 * lane); wk[k] = *(const u32x4*)(row0 + (size_t)k * INW + C_GK + 8 * lk); }
        const f32x4 gq0 = *(const f32x4*)(a.in[I_QNG] + l * 64 + 8 * sub), gq1 = *(const f32x4*)(a.in[I_QNG] + l * 64 + 8 * sub + 4);
        const f32x4 gk0 = *(const f32x4*)(a.in[I_KNG] + l * 64 + 8 * sub), gk1 = *(const f32x4*)(a.in[I_KNG] + l * 64 + 8 * sub + 4);
        if (lat) {
#pragma unroll
            for (int k = 0; k < 4; ++k) { const int pos = quarter < 2 ? (t0 >> 6) : ((t0 & 63) + k); const unsigned* r_ = rope + pos * 16 + (sub & 1) * 8; rp[k][0] = *(const u32x4*)r_; rp[k][1] = *(const u32x4*)(r_ + 4); } }
#pragma unroll
        for (int pass = 0; pass < 2; ++pass) {
            const float gw8[8] = {pass ? gk0[0] : gq0[0] * C2, pass ? gk0[1] : gq0[1] * C2, pass ? gk0[2] : gq0[2] * C2, pass ? gk0[3] : gq0[3] * C2, pass ? gk1[0] : gq1[0] * C2, pass ? gk1[1] : gq1[1] * C2, pass ? gk1[2] : gq1[2] * C2, pass ? gk1[3] : gq1[3] * C2};
#pragma unroll
            for (int k = 0; k < 4; ++k) { const int t = t0 + k; float x[8]; bf8_unpack(pass ? wk[k] : wq[k], x);
                float ss = 0.f;
#pragma unroll
                for (int i = 0; i < 8; ++i) ss += x[i] * x[i];
                ss += __shfl_xor(ss, 1); ss += __shfl_xor(ss, 2); ss += __shfl_xor(ss, 4);
                const float rn = 1.0f / sqrtf(ss * (1.f / 64.f) + 1e-6f);
#pragma unroll
                for (int i = 0; i < 8; ++i) x[i] = x[i] * rn * gw8[i];
                if (lat) {
#pragma unroll
                    for (int i = 0; i < 8; ++i) { const float pr = __shfl_xor(x[i], 2); const unsigned cs_ = rp[k][i >> 2][i & 3]; const float cs = h16lo(cs_), sn = h16hi(cs_);
                        x[i] = (quarter & 1) ? (pr * sn + x[i] * cs) : (x[i] * cs - pr * sn); } }
                u32x4 o; o.x = cvt_pk_bf16(x[0], x[1]); o.y = cvt_pk_bf16(x[2], x[3]); o.z = cvt_pk_bf16(x[4], x[5]); o.w = cvt_pk_bf16(x[6], x[7]);
                if (pass == 0) *(u32x4*)(row0 + (size_t)k * INW + C_GQ + 8 * lane) = o;
                else if (lane < 16) { *(u32x4*)(row0 + (size_t)k * INW + C_GK + 8 * lane) = o;
                    if (!lat) { float* so = a.out + O_SGK + ((size_t)((tok0 >> 8) * 4 + l) * 256 + t) * 128 + 8 * lane; *(f32x4*)so = (f32x4){x[0], x[1], x[2], x[3]}; *(f32x4*)(so + 4) = (f32x4){x[4], x[5], x[6], x[7]}; } } }
        }
        asm volatile("" ::: "memory");
        u32x4 cw[6], hw[6], bw[4];
#pragma unroll
        for (int rr = 0; rr < 6; ++rr) { const int tt = t0 - 1 + rr; const bool ok = tt >= 0 && tt < L; const bf16_t* p = ok ? row0 + (ptrdiff_t)(rr - 1) * INW + C_CVC + c0 : zrow; cw[rr] = *(const u32x4*)p; hw[rr] = *(const u32x4*)(ok ? p + (C_CVH - C_CVC) : zrow); }
#pragma unroll
        for (int k = 0; k < 4; ++k) bw[k] = *(const u32x4*)(row0 + (size_t)k * INW + C_CVB + c0);
        const float* cb = a.in[I_CONVB] + l * 512 + c0; const float* wk_ = a.in[I_CONVW] + (size_t)l * 3 * 512 + c0;
        const f32x4 cwt[8] = {*(const f32x4*)wk_, *(const f32x4*)(wk_ + 4), *(const f32x4*)(wk_ + 512), *(const f32x4*)(wk_ + 516), *(const f32x4*)(wk_ + 1024), *(const f32x4*)(wk_ + 1028), *(const f32x4*)cb, *(const f32x4*)(cb + 4)};
        u32x4 pa[8];
#pragma unroll
        for (int i = 0; i < 8; ++i) pa[i] = POOL_LD(i, i < 2 * half && t0 - half + i >= 0);
        { float u[6][8];
#pragma unroll
          for (int rr = 0; rr < 6; ++rr) { const int tt = t0 - 1 + rr; float c_[8], h_[8]; bf8_unpack(cw[rr], c_); bf8_unpack(hw[rr], h_);
#pragma unroll
              for (int i = 0; i < 8; ++i) u[rr][i] = c_[i] * h_[i]; }
#pragma unroll
          for (int k = 0; k < 4; ++k) { float b_[8], y[8]; bf8_unpack(bw[k], b_);
#pragma unroll
              for (int i = 0; i < 8; ++i) y[i] = b_[i] * (cwt[6 + (i >> 2)][i & 3] + cwt[i >> 2][i & 3] * u[k][i] + cwt[2 + (i >> 2)][i & 3] * u[k + 1][i] + cwt[4 + (i >> 2)][i & 3] * u[k + 2][i]);
              u32x2 o; o.x = cvt4_fp8_sat(y[0], y[1], y[2], y[3]); o.y = cvt4_fp8_sat(y[4], y[5], y[6], y[7]);
              *(u32x2*)(BR + (size_t)(tok0 + k) * BRW + 1024 + c0) = o; } }
        asm volatile("" ::: "memory");
        { u32x4 pb[8];
#pragma unroll
          for (int i = 0; i < 8; ++i) pb[i] = POOL_LD(8 + i, 8 + i < 2 * half && t0 - half + 8 + i < L);
          float S[8];
#pragma unroll
          for (int j = 0; j < 8; ++j) S[j] = 0.f;
#pragma unroll
          for (int i = 0; i < 8; ++i) { float v[8]; bf8_unpack(pa[i], v);
#pragma unroll
              for (int j = 0; j < 8; ++j) S[j] += v[j]; }
          asm volatile("" ::: "memory");
          u32x4 ph[3], pt[3], po[4];
#pragma unroll
          for (int j = 0; j < 3; ++j) { ph[j] = POOL_LD(j, t0 - half + j >= 0); pt[j] = POOL_LD(2 * half + j, t0 + half + j < L); }
#pragma unroll
          for (int k = 0; k < 4; ++k) po[k] = POOL_LD(half + k, true);
#pragma unroll
          for (int i = 0; i < 8; ++i) { float v[8]; bf8_unpack(pb[i], v);
#pragma unroll
              for (int j = 0; j < 8; ++j) S[j] += v[j]; }
#pragma unroll
          for (int k = 0; k < 4; ++k) { const int t = t0 + k; const float ic = 1.0f / (float)(min(t + half, L) - max(t - half, 0)); float own[8]; bf8_unpack(po[k], own);
              u32x2 o; o.x = cvt4_fp8_sat(S[0] * ic - own[0], S[1] * ic - own[1], S[2] * ic - own[2], S[3] * ic - own[3]); o.y = cvt4_fp8_sat(S[4] * ic - own[4], S[5] * ic - own[5], S[6] * ic - own[6], S[7] * ic - own[7]);
              *(u32x2*)(BR + (size_t)(tok0 + k) * BRW + 1536 + c0) = o;
              if (k < 3) { float vh[8], vt[8]; bf8_unpack(ph[k], vh); bf8_unpack(pt[k], vt);
#pragma unroll
                  for (int j = 0; j < 8; ++j) S[j] += vt[j] - vh[j]; } } }
    }
}

#undef POOL_LD
__device__ __forceinline__ void ph_ln1(const Args& a, int l, LAS unsigned char* lds, int tid, int gw, int NGW, int lane) {
    LAS float* wrT = (LAS float*)lds;
    LAS float* gS = wrT + 16384; LAS float* bS = gS + 1024;
    { const f32x4* src = (const f32x4*)(a.in[I_WR] + (size_t)l * 1024 * 16); f32x4 w[8];
#pragma unroll
      for (int j = 0; j < 8; ++j) w[j] = src[tid + 512 * j];
      const f32x4 gb = *(const f32x4*)((tid < 256 ? a.in[I_LN1G] : a.in[I_LN1B]) + l * 1024 + 4 * (tid & 255));
#pragma unroll
      for (int j = 0; j < 8; ++j) { const int q = tid + 512 * j, k = q >> 2, e0 = (q & 3) * 4, pk = (k >> 9) * 512 + ((k >> 2) & 1) * 256 + ((k >> 3) & 63) * 4 + (k & 3);
#pragma unroll
          for (int i = 0; i < 4; ++i) wrT[(e0 + i) * 1024 + pk] = w[j][i]; }
      { const int k = 4 * (tid & 255), pk = (k >> 9) * 512 + ((k >> 2) & 1) * 256 + ((k >> 3) & 63) * 4; *(LAS f32x4*)((tid < 256 ? gS : bS) + pk) = gb; } }
    __syncthreads();
    const float* mod = (const float*)(a.ws + WS_MOD); const bf16_t* V = (const bf16_t*)(a.ws + WS_V); unsigned char* H8 = a.ws + WS_H8;
    float* aff = (float*)(a.ws + WS_AFF); float* afft = (float*)(a.ws + WS_AFFT);
    u32x4 vw[4][2];
    if (gw < NTOK / 4) {
#pragma unroll
        for (int t = 0; t < 4; ++t)
#pragma unroll
            for (int c = 0; c < 2; ++c) vw[t][c] = *(const u32x4*)((const char*)(V + (size_t)(4 * gw + t) * D + 512 * c) + (unsigned)(16 * lane)); }
    for (int q = gw; q < NTOK / 4; q += NGW) {
        const int t0 = 4 * q; const char* mp = (const char*)(mod + (size_t)(l * 9 + modrow_of_tok(t0)) * 6144);
        f32x4 msc[2][2], msh[2][2];
#pragma unroll
        for (int c = 0; c < 2; ++c)
#pragma unroll
            for (int h = 0; h < 2; ++h) { msc[c][h] = *(const f32x4*)(mp + (4 * 1024 + 512 * c + 4 * h) * 4 + (unsigned)(32 * lane)); msh[c][h] = *(const f32x4*)(mp + (3 * 1024 + 512 * c + 4 * h) * 4 + (unsigned)(32 * lane)); }
        float v[4][2][8];
#pragma unroll
        for (int t = 0; t < 4; ++t)
#pragma unroll
            for (int c = 0; c < 2; ++c) { const u32x4 w = vw[t][c]; v[t][c][0] = h16lo(w.x); v[t][c][1] = h16hi(w.x); v[t][c][2] = h16lo(w.y); v[t][c][3] = h16hi(w.y); v[t][c][4] = h16lo(w.z); v[t][c][5] = h16hi(w.z); v[t][c][6] = h16lo(w.w); v[t][c][7] = h16hi(w.w); }
        { const int qn = q + NGW;
          if (qn < NTOK / 4) {
#pragma unroll
              for (int t = 0; t < 4; ++t)
#pragma unroll
                  for (int c = 0; c < 2; ++c) vw[t][c] = *(const u32x4*)((const char*)(V + (size_t)(4 * qn + t) * D + 512 * c) + (unsigned)(16 * lane)); } }
        float rstd[4], mean4[4];
#pragma unroll
        for (int t = 0; t < 4; ++t) { float s1 = 0.f;
#pragma unroll
            for (int c = 0; c < 2; ++c)
#pragma unroll
                for (int i = 0; i < 8; i += 4) s1 += (v[t][c][i] + v[t][c][i + 1]) + (v[t][c][i + 2] + v[t][c][i + 3]);
            const float mean = wave_sum(s1) * (1.f / D); float s2 = 0.f;
#pragma unroll
            for (int c = 0; c < 2; ++c)
#pragma unroll
                for (int i = 0; i < 8; ++i) { v[t][c][i] -= mean; s2 += v[t][c][i] * v[t][c][i]; }
            rstd[t] = 1.0f / sqrtf(wave_sum(s2) * (1.f / D) + 1e-6f); mean4[t] = mean; }
        if (lane < 4) { const float mm = lane == 0 ? mean4[0] : lane == 1 ? mean4[1] : lane == 2 ? mean4[2] : mean4[3], rr = lane == 0 ? rstd[0] : lane == 1 ? rstd[1] : lane == 2 ? rstd[2] : rstd[3];
            *(f32x2_t*)(a.ws + WS_STATS + (size_t)(t0 + lane) * 8) = (f32x2_t){mm, rr}; }
#pragma unroll
        for (int c = 0; c < 2; ++c) {
#pragma unroll
            for (int h = 0; h < 2; ++h) { const f32x4 g4 = *(const LAS f32x4*)(gS + c * 512 + h * 256 + 4 * lane), b4 = *(const LAS f32x4*)(bS + c * 512 + h * 256 + 4 * lane);
#pragma unroll
                for (int t = 0; t < 4; ++t)
#pragma unroll
                    for (int i = 0; i < 4; ++i) { const float x1 = v[t][c][4 * h + i] * rstd[t] * g4[i] + b4[i]; v[t][c][4 * h + i] = x1 * (1.0f + msc[c][h][i]) + msh[c][h][i]; } }
#pragma unroll
            for (int t = 0; t < 4; ++t) { const size_t o = (size_t)(t0 + t) * D + 512 * c;
                u32x2 w8; w8.x = cvt4_fp8_sat(v[t][c][0], v[t][c][1], v[t][c][2], v[t][c][3]); w8.y = cvt4_fp8_sat(v[t][c][4], v[t][c][5], v[t][c][6], v[t][c][7]); *(u32x2*)((char*)(H8 + o) + (unsigned)(8 * lane)) = w8; } }
        float p[64];
#pragma unroll
        for (int j = 0; j < 64; ++j) p[j] = 0.f;
#pragma unroll
        for (int c = 0; c < 2; ++c)
#pragma unroll
            for (int e = 0; e < 16; ++e) { const f32x4 w0 = *(const LAS f32x4*)(wrT + e * 1024 + c * 512 + 4 * lane), w1 = *(const LAS f32x4*)(wrT + e * 1024 + c * 512 + 256 + 4 * lane);
#pragma unroll
                for (int t = 0; t < 4; ++t) p[t * 16 + e] += (v[t][c][0] * w0[0] + v[t][c][1] * w0[1]) + (v[t][c][2] * w0[2] + v[t][c][3] * w0[3]) + (v[t][c][4] * w1[0] + v[t][c][5] * w1[1]) + (v[t][c][6] * w1[2] + v[t][c][7] * w1[3]);
                if ((e & 1) == 1) asm volatile("" ::: "memory"); }
#pragma unroll
        for (int j = 0; j < 32; ++j) { const auto r_ = __builtin_amdgcn_permlane32_swap(__float_as_uint(p[j]), __float_as_uint(p[j + 32]), false, false); p[j] = __uint_as_float(r_[0]) + __uint_as_float(r_[1]); }
#pragma unroll
        for (int j = 0; j < 16; ++j) { const auto r_ = __builtin_amdgcn_permlane16_swap(__float_as_uint(p[j]), __float_as_uint(p[j + 16]), false, false); p[j] = __uint_as_float(r_[0]) + __uint_as_float(r_[1]); }
#pragma unroll
        for (int n = 8; n >= 1; n >>= 1) { const bool up = (lane & n) != 0;
#pragma unroll
            for (int j = 0; j < n; ++j) { const float keep = up ? p[j + n] : p[j], send = up ? p[j] : p[j + n]; p[j] = keep + __shfl_xor(send, n); } }
        const float z = p[0]; float mx = z;
#pragma unroll
        for (int o = 1; o < 16; o <<= 1) mx = fmaxf(mx, __shfl_xor(mx, o));
        const float ez = expf(z - mx); const float mine = ez / sum16(ez);
        aff[t0 * 16 + lane] = mine; afft[(size_t)(lane & 15) * NTOK + t0 + (lane >> 4)] = mine;
    }
}

__device__ __forceinline__ int block_excl_scan(int v, LAS int* sc, int tid, int& total) {
    const int lane = tid & 63, w = tid >> 6; int inc = v;
#pragma unroll
    for (int o = 1; o < 64; o <<= 1) { const int t = __shfl_up(inc, o); if (lane >= o) inc += t; }
    if (lane == 63) sc[w] = inc;
    __syncthreads();
    int off = 0, tot = 0;
#pragma unroll
    for (int i = 0; i < 8; ++i) { const int s = sc[i]; off += (i < w) ? s : 0; tot += s; }
    __syncthreads();
    total = tot; return off + inc - v;
}
__device__ __forceinline__ void ph_topk(const Args& a, LAS unsigned char* lds, int G, int bx, int tid) {
    LAS unsigned* keys = (LAS unsigned*)lds; LAS unsigned* hist = keys + 16384 + 512; LAS int* sc = (LAS int*)(hist + 4096); LAS unsigned* bc = (LAS unsigned*)(sc + 16);
    const float* afft = (const float*)(a.ws + WS_AFFT); int* slot = (int*)(a.ws + WS_SLOT); int* idx = (int*)(a.ws + WS_IDX);
    const int lane = tid & 63;
#define KIDX(j) ((j) + ((j) >> 5))
    for (int prob = bx; prob < 32; prob += G) {
        const bool lat = prob >= 16; const int e = prob & 15, n = lat ? NLAT : NCTX, cap = n >> 3, tbase = lat ? NCTX : 0, lbase = lat ? 16384 + e * 2048 : e * 1024;
        { const f32x4* kp = (const f32x4*)(afft + (size_t)e * NTOK + tbase); f32x4 kv[8];
#pragma unroll
          for (int u = 0; u < 8; ++u) { const int i4 = tid + 512 * u; kv[u] = i4 * 4 < n ? kp[i4] : (f32x4){0.f, 0.f, 0.f, 0.f}; }
#pragma unroll
          for (int u = 0; u < 8; ++u) { const int i = 4 * (tid + 512 * u); if (i < n) { keys[KIDX(i)] = __float_as_uint(kv[u][0]); keys[KIDX(i + 1)] = __float_as_uint(kv[u][1]); keys[KIDX(i + 2)] = __float_as_uint(kv[u][2]); keys[KIDX(i + 3)] = __float_as_uint(kv[u][3]); } } }
        unsigned prefix = 0u, mask = 0u; int krem = cap;
#pragma unroll 1
        for (int pass = 0; pass < 3; ++pass) { const int shift = pass == 0 ? 20 : pass == 1 ? 10 : 0, nbin = pass == 0 ? 4096 : 1024;
            for (int i = tid; i < nbin; i += 512) hist[i] = 0u;
            __syncthreads();
#pragma unroll 8
            for (int i = tid; i < n; i += 512) { const unsigned k = keys[KIDX(i)]; if ((k & mask) == prefix) atomicAdd((unsigned*)&hist[(k >> shift) & (unsigned)(nbin - 1)], 1u); }
            __syncthreads();
            { const int per = nbin >> 9; unsigned hb[8], s_ = 0u;
#pragma unroll
              for (int b = 0; b < 8; ++b) { hb[b] = b < per ? hist[per * tid + b] : 0u; s_ += hb[b]; }
              int tot; const int pre = block_excl_scan((int)s_, sc, tid, tot);
              unsigned cum = (unsigned)(tot - pre) - s_;
              if (cum < (unsigned)krem && cum + s_ >= (unsigned)krem) { bool done = false;
#pragma unroll
                  for (int b = 7; b >= 0; --b) { if (b < per && !done) { const unsigned c = hb[b]; if (cum + c >= (unsigned)krem) { bc[0] = prefix | ((unsigned)(per * tid + b) << shift); bc[1] = (unsigned)krem - cum; done = true; } else cum += c; } } } }
            __syncthreads();
            prefix = bc[0]; krem = (int)bc[1]; mask |= (unsigned)(nbin - 1) << shift;
            __syncthreads();
        }
        const unsigned T = prefix; const int C = n >> 9, i0 = tid * C; int ceq = 0;
#pragma unroll 8
        for (int i = 0; i < C; ++i) ceq += (keys[KIDX(i0 + i)] == T) ? 1 : 0;
        int tot; int er = block_excl_scan(ceq, sc, tid, tot); int csel = 0; { int e2 = er;
#pragma unroll 8
            for (int i = 0; i < C; ++i) { const unsigned k = keys[KIDX(i0 + i)]; const bool sel = k > T || (k == T && e2 < krem); e2 += (k == T) ? 1 : 0; csel += sel ? 1 : 0; } }
        int so = block_excl_scan(csel, sc, tid, tot);
#pragma unroll 8
        for (int i = 0; i < C; ++i) { const unsigned k = keys[KIDX(i0 + i)]; const bool sel = k > T || (k == T && er < krem); er += (k == T) ? 1 : 0;
            keys[KIDX(i0 + i)] = sel ? (unsigned)so : 0xffffffffu; if (sel) { idx[lbase + so] = tbase + i0 + i; ++so; } }
        __syncthreads();
#pragma unroll 8
        for (int i = tid; i < n; i += 512) slot[(size_t)e * NTOK + tbase + i] = (int)keys[KIDX(i)];
        __syncthreads();
    }
#undef KIDX
}

__device__ __forceinline__ Args load_args() {
#if defined(__HIP_DEVICE_COMPILE__)
    const __attribute__((address_space(4))) unsigned char* p = (const __attribute__((address_space(4))) unsigned char*)__builtin_amdgcn_kernarg_segment_ptr(); asm volatile("" : "+s"(p));
    return *(const __attribute__((address_space(4))) Args*)p;
#else
    return Args{};
#endif
}
#define PH_VIEW() const Args a = load_args(); const int tid = opaque_v((int)threadIdx.x), lane = tid & 63, wave = __builtin_amdgcn_readfirstlane(tid >> 6); \
    const int G = opaque_s((int)gridDim.x), bx = opaque_s((int)blockIdx.x), gw = bx * 8 + wave, NGW = G * 8; LAS unsigned char* lds = (LAS unsigned char*)smem; (void)lane; (void)wave; (void)gw; (void)NGW; (void)lds; (void)tid
constexpr int N_PHASES = 2 + 10 * DEPTH;
#ifndef PH_MASK
#define PH_MASK 0xFFFF
#endif
#define PHON(j) (((PH_MASK) >> (j)) & 1)
#ifndef ATT_SHADOW
#define ATT_SHADOW 0
#endif
#ifndef XCD_STAGGER
#define XCD_STAGGER 0
#endif
#ifndef XCD_STAGGER2
#define XCD_STAGGER2 0
#endif
#ifndef REP_MASK
#define REP_MASK 0
#endif
#define NREP(j) (1 + (((REP_MASK) >> (j)) & 1))
__global__ void __launch_bounds__(512, 2) mk_fwd(Args a_) {
    extern __shared__ __attribute__((aligned(16))) unsigned char smem[];
    { volatile LAS unsigned* MISC = (volatile LAS unsigned*)((LAS unsigned char*)smem + MISC_OFF);
      if (threadIdx.x < 32) MISC[threadIdx.x] = 0u;
      __syncthreads();
      (void)xcd_barrier_post((unsigned*)(a_.ws + WS_CTL) + CW_BAR, MISC + 8); }
    const int lo = a_.ph_lo, hi = a_.ph_hi;
#define STAGGER(step) do { if (step) { const unsigned long long t0_ = __builtin_amdgcn_s_memrealtime(), dt_ = (unsigned long long)((xb_xcc_id() & 7u) * (step)); while (__builtin_amdgcn_s_memrealtime() - t0_ < dt_) __builtin_amdgcn_s_sleep(8); } } while (0)
#define IN(k) (lo <= (k) && (k) < hi)
#define SEAM(k) do { if (IN(k) && IN((k) + 1)) { const Args sa = load_args(); XcdBarrier b; b.bar = (unsigned*)(sa.ws + WS_CTL) + CW_BAR; b.x = xb_xcc_id(); b.st = (volatile LAS unsigned*)((LAS unsigned char*)smem + MISC_OFF) + 8; xcd_barrier(b); } } while (0)
#define SEAMF() do { const Args sa = load_args(); XcdBarrier b; b.bar = (unsigned*)(sa.ws + WS_CTL) + CW_BAR; b.x = xb_xcc_id(); b.st = (volatile LAS unsigned*)((LAS unsigned char*)smem + MISC_OFF) + 8; xcd_barrier(b); } while (0)
#define SLACK_CONV(nwg, off, cap) do { const int base_ = EARLY + l * LAYER_ITEMS + (off), cnt_ = min((cap), NT_ITEMS - base_), f_ = (nwg) % G; if (cnt_ > 0 && bx >= f_) conv_loop(a, (LAS float*)(lds + wave * 16384), lane, (bx - f_) * 8 + wave, (G - f_) * 8, cnt_, base_); } while (0)
    if (PHON(10) && IN(0)) for (int rep_ = 0; rep_ < NREP(10); ++rep_) { if (rep_) { SEAMF(); } { PH_VIEW(); ph_prologue(a, lds, G, bx, tid, wave, lane); } }
    SEAM(0);
    for (int l = 0; l < DEPTH; ++l) {
        const int pb = 1 + 10 * l;
        if (PHON(0) && IN(pb + 0)) { PH_VIEW(); ph_x(a, l, lds, tid, gw, NGW, lane); }
        SEAM(pb + 0);
        if (PHON(1) && IN(pb + 1)) for (int rep_ = 0; rep_ < NREP(1); ++rep_) { if (rep_) { SEAMF(); } { PH_VIEW(); STAGGER(XCD_STAGGER);
            { pg8::SchedLin S{G, bx, 96, C_F8 / 256, 1, (const char*)(a.ws + WS_H), (const char*)(a.ws + WS_WI) + (size_t)l * INW * 1024 * 2, 1024, 1024, 0, 0, 6};
              pg8::EpiWin E{(bf16_t*)(a.ws + WS_BIG), a.out, l}; pg8::gemm_phase(lds, 1024, S, E); }
            { pg8::SchedLin S{G, bx, 96, NF8 / 256, 1, (const char*)(a.ws + WS_H8), (const char*)(a.ws + WS_WI8) + (size_t)l * NF8 * 1024, 512, 512, 0, 0, 3};
              pg8::EpiWinGate E{(bf16_t*)(a.ws + WS_BIG)}; pg8::gemm_phase(lds, 512, S, E); }
            SLACK_CONV(96 * (C_F8 / 256), OFF_A, SLICE_A); } }
        SEAM(pb + 1);
        if (PHON(2) && IN(pb + 2)) { PH_VIEW(); ph_thin(a, l, gw, NGW, lane); }
        SEAM(pb + 2);
        if (PHON(3) && IN(pb + 3)) for (int rep_ = 0; rep_ < NREP(3); ++rep_) { if (rep_) { SEAMF(); } { PH_VIEW(); ph_attention<0>(a, l, lds, G, bx); if (ATT_SHADOW) ph_attention<ATT_SHADOW>(a, l, lds, G, bx); } }
        SEAM(pb + 3);
        if (PHON(4) && IN(pb + 4)) for (int rep_ = 0; rep_ < NREP(4); ++rep_) { if (rep_) { SEAMF(); } { PH_VIEW(); STAGGER(XCD_STAGGER2); pg8::SchedLin S{G, bx, 96, 4, 4, (const char*)(a.ws + WS_BR), (const char*)(a.ws + WS_WBR) + (size_t)l * 4 * 1024 * 512, BRW / 2, 256, 512, (size_t)1024 * 512, 8};
            pg8::EpiBranch E{(const bf16_t*)(a.ws + WS_BIG), (bf16_t*)(a.ws + WS_MRG)}; pg8::gemm_phase(lds, 256, S, E); SLACK_CONV(96 * 4, OFF_B, SLICE_B); } }
        SEAM(pb + 4);
        if (PHON(5) && IN(pb + 5)) for (int rep_ = 0; rep_ < NREP(5); ++rep_) { if (rep_) { SEAMF(); } { PH_VIEW(); STAGGER(XCD_STAGGER2); pg8::SchedLin S{G, bx, 96, 4, 1, (const char*)(a.ws + WS_MRG), (const char*)(a.ws + WS_WO) + (size_t)l * 1024 * 1024 * 2, 1024, 1024, 0, 0, 8};
            pg8::EpiWout E{(const bf16_t*)(a.ws + WS_XB), (const float*)(a.ws + WS_MOD) + (size_t)l * 9 * 6144, (bf16_t*)(a.ws + WS_V)}; pg8::gemm_phase(lds, 1024, S, E); SLACK_CONV(96 * 4, OFF_C, SLICE_C); } }
        SEAM(pb + 5);
        if (PHON(6) && IN(pb + 6)) for (int rep_ = 0; rep_ < NREP(6); ++rep_) { if (rep_) { SEAMF(); } { PH_VIEW(); ph_ln1(a, l, lds, tid, gw, NGW, lane); } }
        SEAM(pb + 6);
        if (PHON(7) && IN(pb + 7)) for (int rep_ = 0; rep_ < NREP(7); ++rep_) { if (rep_) { SEAMF(); } { PH_VIEW(); ph_topk(a, lds, G, bx, tid);
            { const int cb0 = G > 32 ? 32 : 0, base_ = EARLY + l * LAYER_ITEMS + OFF_T, cnt_ = min(SLICE_T, NT_ITEMS - base_); if (cnt_ > 0 && bx >= cb0) conv_loop(a, (LAS float*)(lds + wave * 16384), lane, (bx - cb0) * 8 + wave, (G - cb0) * 8, cnt_, base_);
              if (l + 1 < DEPTH && bx >= cb0) cache_conv(a, lane, (bx - cb0) * 8 + wave, (G - cb0) * 8, l + 1); } } }
        SEAM(pb + 7);
        if (PHON(8) && IN(pb + 8)) for (int rep_ = 0; rep_ < NREP(8); ++rep_) { if (rep_) { SEAMF(); } { PH_VIEW(); STAGGER(XCD_STAGGER2); pg8::SchedGU S{G, bx, (const char*)(a.ws + WS_H8), (const char*)(a.ws + WS_WGU8) + (size_t)l * 16 * 2048 * 1024, (const int*)(a.ws + WS_IDX)};
            pg8::EpiGU E{a.ws + WS_HDN}; pg8::gemm_phase(lds, 512, S, E); } }
        SEAM(pb + 8);
        if (PHON(9) && IN(pb + 9)) for (int rep_ = 0; rep_ < NREP(9); ++rep_) { if (rep_) { SEAMF(); } { PH_VIEW(); STAGGER(XCD_STAGGER2); pg8::SchedDown S{G, bx, (const char*)(a.ws + WS_HDN), (const char*)(a.ws + WS_WD8) + (size_t)l * 16 * 1024 * 1024};
            pg8::EpiDown E{a.ws + WS_YE}; pg8::gemm_phase(lds, 512, S, E); } }
        SEAM(pb + 9);
    }
    if (PHON(0) && IN(N_PHASES - 1)) { PH_VIEW(); ph_x(a, DEPTH, lds, tid, gw, NGW, lane); }
#undef IN
#undef SEAM
}

extern "C" void kernel_launch(void* const* d_in, const int* in_sizes, int n_in, void* d_out, int out_size, void* d_ws, size_t ws_size, hipStream_t stream) {
    static int grid = 0;
    if (grid == 0) {
        if (n_in != 28 || (size_t)out_size != O_END || ws_size < WS_END) { fprintf(stderr, "kernel_launch: unexpected problem (n_in %d, out %d, ws %zu); nothing launched\n", n_in, out_size, ws_size); grid = -1; return; }
        int dev = 0, cus = 0, per_cu = 0;
        if (hipGetDevice(&dev) != hipSuccess || hipDeviceGetAttribute(&cus, hipDeviceAttributeMultiprocessorCount, dev) != hipSuccess) { grid = -1; return; }
        if (hipFuncSetAttribute((const void*)mk_fwd, hipFuncAttributeMaxDynamicSharedMemorySize, LDS_BYTES) != hipSuccess) { fprintf(stderr, "kernel_launch: hipFuncSetAttribute failed\n"); grid = -1; return; }
        if (hipOccupancyMaxActiveBlocksPerMultiprocessor(&per_cu, (const void*)mk_fwd, 512, LDS_BYTES) != hipSuccess || per_cu < 1) { fprintf(stderr, "kernel_launch: occupancy query reports %d blocks per CU\n", per_cu); }
        (void)hipGetLastError();
        grid = cus;
    }
    if (grid < 0) return;
    (void)hipMemsetAsync((char*)d_ws + WS_CTL, 0, CTL_BYTES, stream);
    Args a{};
    for (int i = 0; i < 28; ++i) a.in[i] = (const float*)d_in[i];
    a.out = (float*)d_out; a.ws = (unsigned char*)d_ws;
#if MK_ONE_LAUNCH
    a.ph_lo = 0; a.ph_hi = N_PHASES;
    hipLaunchKernelGGL(mk_fwd, dim3(grid), dim3(512), LDS_BYTES, stream, a);
#else
    for (int p = 0; p < N_PHASES; ++p) { a.ph_lo = p; a.ph_hi = p + 1; hipLaunchKernelGGL(mk_fwd, dim3(grid), dim3(512), LDS_BYTES, stream, a); }
#endif
}
```
